# Optimizing an MI355X kernel written in HIP

```python
import math
import jax, jax.numpy as jnp
from jax import lax
import numpy as np

D_MODEL = 2048
BATCH = 2
SEQ = 4096
DEPTH = 1

D_MIX = D_MODEL
D_S5 = D_MIX // 2
D_GLA = D_MIX - D_S5
S5_GROUP = 16
S5_GROUPS = D_S5 // S5_GROUP
S5_STATE = 64
GLA_HEADS = 4
GLA_DK = D_GLA // 2
GLA_DV = D_GLA
GLA_HK = GLA_DK // GLA_HEADS
GLA_HV = GLA_DV // GLA_HEADS
GLA_RANK = 16
GLA_TAU = 16.0
GLA_CHUNK = 64
EPS = 1e-6
D_IN = 2 * D_S5 + 2 * GLA_DK + 2 * GLA_DV + GLA_RANK

kernel_name = "hybrid_s5_gla_parallel_heads"


def rmsnorm(x, w):
    xf = x.astype(jnp.float32)
    return xf * lax.rsqrt(jnp.mean(xf * xf, axis=-1, keepdims=True) + EPS) * w.astype(jnp.float32)


def s5_branch(u, A_re, A_im, B_re, B_im, C_re, C_im, D, log_dt, glu_w, glu_b):
    bsz, L, _ = u.shape
    ug = u.reshape(bsz, L, S5_GROUPS, S5_GROUP)
    a_re = jnp.minimum(A_re.astype(jnp.float32), -1e-4)
    A = lax.complex(a_re, A_im.astype(jnp.float32))
    dt = jnp.exp(log_dt.astype(jnp.float32))[:, None]
    A_bar = jnp.exp(A * dt)
    Bc = lax.complex(B_re.astype(jnp.float32), B_im.astype(jnp.float32))
    B_bar = ((A_bar - 1.0) / A)[..., None] * Bc
    Bu = jnp.einsum('blgh,gph->blgp', ug.astype(jnp.complex64), B_bar)
    a_seq = jnp.broadcast_to(A_bar, Bu.shape)

    def combine(e1, e2):
        a1, b1 = e1
        a2, b2 = e2
        return a1 * a2, a2 * b1 + b2

    _, states = lax.associative_scan(combine, (a_seq, Bu), axis=1)
    Cc = lax.complex(C_re.astype(jnp.float32), C_im.astype(jnp.float32))
    y = jnp.real(jnp.einsum('blgp,ghp->blgh', states, Cc))
    y = y + D.astype(jnp.float32).reshape(S5_GROUPS, S5_GROUP) * ug
    y = jax.nn.gelu(y.reshape(bsz, L, D_S5))
    return y * jax.nn.sigmoid(y @ glu_w.astype(jnp.float32) + glu_b.astype(jnp.float32))


def gla_branch(q, k, v, g_low, gate_up, gate_bias, norm_w):
    bsz, L, _ = q.shape
    n = L // GLA_CHUNK

    def heads(t, d):
        return t.reshape(bsz, n, GLA_CHUNK, GLA_HEADS, d).transpose(0, 3, 1, 2, 4)

    log_g = jax.nn.log_sigmoid(g_low @ gate_up.astype(jnp.float32)
                               + gate_bias.astype(jnp.float32)) / GLA_TAU
    q = heads(q, GLA_HK) * (GLA_HK ** -0.5)
    k = heads(k, GLA_HK)
    v = heads(v, GLA_HV)
    log_g = heads(log_g, GLA_HK)
    b = jnp.cumsum(log_g, axis=3)
    b_last = b[:, :, :, -1:, :]
    q_e = q * jnp.exp(b)
    k_e = k * jnp.exp(-b)
    k_tail = k * jnp.exp(b_last - b)
    mask = jnp.tril(jnp.ones((GLA_CHUNK, GLA_CHUNK), dtype=bool))
    attn = jnp.where(mask, jnp.einsum('bhncd,bhnsd->bhncs', q_e, k_e), 0.0)
    o_intra = jnp.einsum('bhncs,bhnse->bhnce', attn, v)

    kv = jnp.einsum('bhncd,bhnce->bhnde', k_tail, v)
    decay = jnp.exp(b_last[:, :, :, 0, :])

    def step(S, inp):
        kv_n, dec_n = inp
        return dec_n[..., None] * S + kv_n, S

    S0 = jnp.zeros((bsz, GLA_HEADS, GLA_HK, GLA_HV), jnp.float32)
    _, S_prev = lax.scan(step, S0, (kv.transpose(2, 0, 1, 3, 4), decay.transpose(2, 0, 1, 3)))
    S_prev = S_prev.transpose(1, 2, 0, 3, 4)
    o = o_intra + jnp.einsum('bhncd,bhnde->bhnce', q_e, S_prev)
    o = rmsnorm(o, norm_w)
    return o.transpose(0, 2, 3, 1, 4).reshape(bsz, L, GLA_DV)


def setup_inputs(seed: int = 0) -> dict:
    key = jax.random.key(seed)
    ks = jax.random.split(key, 20)
    f32 = jnp.float32
    nrm = lambda k, shape, s: jax.random.normal(k, shape, f32) * s
    x = jax.random.normal(ks[0], (BATCH, SEQ, D_MODEL), f32)
    pre_norm_w = 1.0 + nrm(ks[1], (DEPTH, D_MODEL), 0.02)
    w_in = nrm(ks[2], (DEPTH, D_MODEL, D_IN), D_MODEL ** -0.5)
    s5_A_re = -0.5 + nrm(ks[3], (DEPTH, S5_GROUPS, S5_STATE), 0.01)
    s5_A_im = (math.pi * jnp.arange(S5_STATE, dtype=f32))[None, None, :] \
        + nrm(ks[4], (DEPTH, S5_GROUPS, S5_STATE), 0.01)
    bs = (2.0 * S5_GROUP) ** -0.5
    cs = (2.0 * S5_STATE) ** -0.5
    s5_B_re = nrm(ks[5], (DEPTH, S5_GROUPS, S5_STATE, S5_GROUP), bs)
    s5_B_im = nrm(ks[6], (DEPTH, S5_GROUPS, S5_STATE, S5_GROUP), bs)
    s5_C_re = nrm(ks[7], (DEPTH, S5_GROUPS, S5_GROUP, S5_STATE), cs)
    s5_C_im = nrm(ks[8], (DEPTH, S5_GROUPS, S5_GROUP, S5_STATE), cs)
    s5_D = nrm(ks[9], (DEPTH, D_S5), 1.0)
    s5_log_dt = jax.random.uniform(ks[10], (DEPTH, S5_GROUPS), f32,
                                   math.log(1e-3), math.log(1e-1))
    s5_glu_w = nrm(ks[11], (DEPTH, D_S5, D_S5), D_S5 ** -0.5)
    s5_glu_b = nrm(ks[12], (DEPTH, D_S5), 0.01)
    gla_gate_up = nrm(ks[13], (DEPTH, GLA_RANK, GLA_DK), GLA_RANK ** -0.5)
    gla_gate_bias = nrm(ks[14], (DEPTH, GLA_DK), 0.1)
    gla_norm_w = 1.0 + nrm(ks[15], (DEPTH, GLA_HV), 0.02)
    w_out = nrm(ks[16], (DEPTH, D_MIX, D_MODEL), D_MIX ** -0.5)
    post_norm_w = 1.0 + nrm(ks[17], (DEPTH, D_MODEL), 0.02)
    return {"x": x, "pre_norm_w": pre_norm_w, "w_in": w_in,
            "s5_A_re": s5_A_re, "s5_A_im": s5_A_im, "s5_B_re": s5_B_re, "s5_B_im": s5_B_im,
            "s5_C_re": s5_C_re, "s5_C_im": s5_C_im, "s5_D": s5_D, "s5_log_dt": s5_log_dt,
            "s5_glu_w": s5_glu_w, "s5_glu_b": s5_glu_b,
            "gla_gate_up": gla_gate_up, "gla_gate_bias": gla_gate_bias, "gla_norm_w": gla_norm_w,
            "w_out": w_out, "post_norm_w": post_norm_w}


def reference(x, pre_norm_w, w_in, s5_A_re, s5_A_im, s5_B_re, s5_B_im, s5_C_re, s5_C_im,
              s5_D, s5_log_dt, s5_glu_w, s5_glu_b, gla_gate_up, gla_gate_bias, gla_norm_w,
              w_out, post_norm_w):
    out_dtype = x.dtype
    resid = x.astype(jnp.float32)
    splits = [D_S5, 2 * D_S5, 2 * D_S5 + GLA_DK, 2 * D_S5 + 2 * GLA_DK,
              2 * D_S5 + 2 * GLA_DK + GLA_DV, 2 * D_S5 + 2 * GLA_DK + 2 * GLA_DV]
    for l in range(DEPTH):
        h = rmsnorm(resid, pre_norm_w[l])
        proj = h @ w_in[l].astype(jnp.float32)
        s5_u, s5_z, q, k, v, gla_z, g_low = jnp.split(proj, splits, axis=-1)
        y_s5 = s5_branch(s5_u, s5_A_re[l], s5_A_im[l], s5_B_re[l], s5_B_im[l],
                         s5_C_re[l], s5_C_im[l], s5_D[l], s5_log_dt[l],
                         s5_glu_w[l], s5_glu_b[l]) * jax.nn.silu(s5_z)
        y_gla = gla_branch(q, k, v, g_low, gla_gate_up[l], gla_gate_bias[l],
                           gla_norm_w[l]) * jax.nn.silu(gla_z)
        mixed = jnp.concatenate([y_s5, y_gla], axis=-1) @ w_out[l].astype(jnp.float32)
        resid = resid + rmsnorm(mixed, post_norm_w[l])
    return resid.astype(out_dtype)
```

```cpp
#include <hip/hip_runtime.h>
#include <cstdio>
#include <cstdint>

#define MK_ONE_LAUNCH 0
#define FAST_GEMM 1
#define FAST_S5 0
#define FAST_GLA 0

namespace pg8 {
#define PG8_LAS __attribute__((address_space(3)))
typedef unsigned short bf16_t;
typedef short bf16x8 __attribute__((ext_vector_type(8)));
typedef float f32x4 __attribute__((ext_vector_type(4)));
typedef unsigned u32x4 __attribute__((ext_vector_type(4)));
constexpr int BM = 256, BK = 64, HALF = 128, HTB = HALF * BK * 2  , STAGE_BYTES = 8 * HTB, NXCD = 8, WGM = 8;

__host__ __device__ __forceinline__ int lds_byte(int r, int c) { const int st = (r >> 4) * 2 + (c >> 5), rr = r & 15, cc = c & 31, ob = rr * 64 + cc * 2; return st * 1024 + (ob ^ (((ob >> 9) & 1) << 5)); }
__host__ __device__ __forceinline__ void stage_rc(int b, int& R, int& C) { const int st = b / 1024, sb = b % 1024, swz = sb ^ (((sb >> 9) & 1) << 5); R = (st >> 1) * 16 + swz / 64; C = (st & 1) * 32 + (swz % 64) / 2; }
__host__ __device__ __forceinline__ int perm32(int rho) { const int n = rho >> 4, i = rho & 15; return 8 * (i >> 2) + 4 * n + (i & 3); }

struct Unit { int pm, pn; };
struct Gemm { const bf16_t* A; const bf16_t* Bt; int M, N, K; };

struct StaticOrder {
    int nM, nN, nwg, G, c;
    __host__ __device__ void init(int M, int N, int G_, int c_) { nM = M / BM; nN = N / BM; nwg = nM * nN; G = G_; c = c_; }
    __host__ __device__ bool next(int i, Unit& u) const {
        const long L = (long)i * G + c; if (L >= nwg) return false;
        int wgid = (int)L; { const int q = nwg / NXCD, r = nwg % NXCD, xcd = wgid % NXCD, off = wgid / NXCD; wgid = (xcd < r ? xcd * (q + 1) : r * (q + 1) + (xcd - r) * q) + off; }
        const int nig = WGM * nN, gid = wgid / nig, fm = gid * WGM, gsz = (nM - fm) < WGM ? (nM - fm) : WGM;
        u.pm = fm + ((wgid % nig) % gsz); u.pn = (wgid % nig) / gsz; return true;
    }
    __device__ __forceinline__ void a_ready(const Unit&) const {}
    __device__ __forceinline__ void done(const Unit&) const {}
};

__device__ __forceinline__ unsigned cvt_pk_bf16(float lo, float hi) { unsigned r; asm volatile("v_cvt_pk_bf16_f32 %0, %1, %2" : "=v"(r) : "v"(lo), "v"(hi)); return r; }
typedef float f32x2 __attribute__((ext_vector_type(2)));
__device__ __forceinline__ f32x2 gelu_pk(f32x2 v) {
    const f32x2 av = __builtin_elementwise_abs(v), d = av * 0.2316418882f + 1.0f;
    f32x2 t; t.x = __builtin_amdgcn_rcpf(d.x); t.y = __builtin_amdgcn_rcpf(d.y);
    f32x2 q = t * 0.5307027145f + (-0.7265760135f); q = q * t + 0.7107068705f; q = q * t + (-0.142248368f); q = q * t + 0.127414796f; q = q * t;
    const f32x2 s = (v * v) * (-0.72134752044f);
    f32x2 e; e.x = __builtin_amdgcn_exp2f(s.x); e.y = __builtin_amdgcn_exp2f(s.y);
    const f32x2 m = v * (q * e), r = v - m;
    f32x2 o; o.x = v.x < 0.f ? m.x : r.x; o.y = v.y < 0.f ? m.y : r.y; return o;
}

template <int ACT  > struct EpiBf16 {
    static constexpr bool PERM = true, AFTER_DRAIN = false; static_assert(ACT == 0 || ACT == 1, "EpiBf16: ACT is 0 (none) or 1 (gelu_pk)");
    bf16_t* O; int ldc; const float* bias; int split_cols; size_t split_stride; float scale0;
    __device__ __forceinline__ void operator()(const f32x4 (&acc)[2][2][4][2], const Unit& u, int wr, int wc, int fr, int fq) const {
        const int row0 = u.pm * BM + wr * 64 + fr; int colt = u.pn * BM; bf16_t* base = O;
        float sc = 1.f; if (split_cols) { const int t = colt / split_cols; base += (size_t)t * split_stride; colt -= t * split_cols; if (t == 0) sc = scale0; }
        const int col0 = colt + wc * 32 + 8 * fq, bcol0 = u.pn * BM + wc * 32 + 8 * fq;
        f32x4 bv[2][2];
#pragma unroll
        for (int bj = 0; bj < 2; ++bj)
#pragma unroll
            for (int n = 0; n < 2; ++n) bv[bj][n] = bias ? *(const f32x4*)(bias + bcol0 + bj * HALF + 4 * n) : (f32x4){0.f, 0.f, 0.f, 0.f};
#pragma unroll
        for (int ai = 0; ai < 2; ++ai)
#pragma unroll
            for (int m = 0; m < 4; ++m) { bf16_t* rowp = base + (size_t)(row0 + ai * HALF + m * 16) * ldc + col0;
#pragma unroll
                for (int bj = 0; bj < 2; ++bj) { f32x4 v0 = acc[ai][bj][m][0] + bv[bj][0], v1 = acc[ai][bj][m][1] + bv[bj][1];
                    if (ACT == 1) { f32x2 a = gelu_pk((f32x2){v0[0], v0[1]}), b = gelu_pk((f32x2){v0[2], v0[3]}), c = gelu_pk((f32x2){v1[0], v1[1]}), d = gelu_pk((f32x2){v1[2], v1[3]});
                        v0 = (f32x4){a.x, a.y, b.x, b.y}; v1 = (f32x4){c.x, c.y, d.x, d.y}; }
                    v0 = v0 * sc; v1 = v1 * sc; u32x4 w; w.x = cvt_pk_bf16(v0[0], v0[1]); w.y = cvt_pk_bf16(v0[2], v0[3]); w.z = cvt_pk_bf16(v1[0], v1[1]); w.w = cvt_pk_bf16(v1[2], v1[3]);
                    *(u32x4*)(rowp + bj * HALF) = w; } }
    }
};

template <class Sink> struct Epi8 {
    static constexpr bool PERM = true, AFTER_DRAIN = false;
    Sink s;
    __device__ __forceinline__ void operator()(const f32x4 (&acc)[2][2][4][2], const Unit& u, int wr, int wc, int fr, int fq) const {
        const int row0 = u.pm * BM + wr * 64 + fr, col0 = u.pn * BM + wc * 32 + 8 * fq;
#pragma unroll
        for (int ai = 0; ai < 2; ++ai)
#pragma unroll
            for (int m = 0; m < 4; ++m)
#pragma unroll
                for (int bj = 0; bj < 2; ++bj) {
                    const f32x4 a0 = acc[ai][bj][m][0], a1 = acc[ai][bj][m][1];
                    const float v[8] = {a0[0], a0[1], a0[2], a0[3], a1[0], a1[1], a1[2], a1[3]};
                    s(row0 + ai * HALF + m * 16, col0 + bj * HALF, v);
                }
    }
};

template <class Epi, class Sched, bool ALIGN_EPI = false, bool SP2 = false>
__device__ __forceinline__ void gemm_phase(PG8_LAS unsigned char* lds, const Gemm g, const Sched& S, const Epi& E) {
    const int tid = threadIdx.x, wid = __builtin_amdgcn_readfirstlane(tid >> 6), lane = tid & 63, wr = wid >> 2, wc = wid & 3, fr = lane & 15, fq = lane >> 4;
    const int K = g.K, nt = K / BK;
    unsigned voffA[2], voffB[2];
#pragma unroll
    for (int i = 0; i < 2; ++i) { int R, C; stage_rc(tid * 16 + i * 8192, R, C); const int Rb = Epi::PERM ? ((R & ~31) + perm32(R & 31)) : R;
        voffA[i] = (unsigned)(R * K + C) * 2u; voffB[i] = (unsigned)(Rb * K + C) * 2u; }
    const size_t kstep = (size_t)(BK * 2);
    const size_t hstep = (size_t)HALF * K * 2;
    const size_t tstep = 2 * hstep;
    const unsigned ldsw = (unsigned)wid * 1024u;
    const int aoff = lds_byte(wr * 64 + fr, fq * 8), boff = lds_byte(wc * 32 + fr, fq * 8);
#define PG8_SA(b, h) (((b) * 2 + (h)) * HTB)
#define PG8_SB(b, h) ((4 + (b) * 2 + (h)) * HTB)
#define PG8_STAGE(bufoff, gbase, voff) do { _Pragma("unroll") for (int _i = 0; _i < 2; ++_i) \
        __builtin_amdgcn_global_load_lds((const unsigned*)((const char*)(gbase) + (voff)[_i]), (PG8_LAS unsigned*)(lds + (bufoff) + ldsw + _i * 8192), 16, 0, 0); } while (0)
#define PG8_LDA(dst, b, h) do { _Pragma("unroll") for (int m = 0; m < 4; ++m) _Pragma("unroll") for (int k = 0; k < 2; ++k) dst[m][k] = *(const PG8_LAS bf16x8*)(lds + PG8_SA(b, h) + aoff + m * 2048 + k * 1024); } while (0)
#define PG8_LDB(dst, b, h) do { _Pragma("unroll") for (int n = 0; n < 2; ++n) _Pragma("unroll") for (int k = 0; k < 2; ++k) dst[n][k] = *(const PG8_LAS bf16x8*)(lds + PG8_SB(b, h) + boff + n * 2048 + k * 1024); } while (0)
#define PG8_MMA(ai, bj, At, Bt) do { __builtin_amdgcn_s_setprio(1); _Pragma("unroll") for (int m = 0; m < 4; ++m) _Pragma("unroll") for (int n = 0; n < 2; ++n) _Pragma("unroll") for (int k = 0; k < 2; ++k) \
        acc[ai][bj][m][n] = __builtin_amdgcn_mfma_f32_16x16x32_bf16(Bt[n][k], At[m][k], acc[ai][bj][m][n], 0, 0, 0); __builtin_amdgcn_s_setprio(0); } while (0)
#define PG8_WAIT_V(n) asm volatile("s_waitcnt vmcnt(" #n ")" ::: "memory")
#define PG8_WAIT_L(n) asm volatile("s_waitcnt lgkmcnt(" #n ")" ::: "memory")
#define PG8_BAR __builtin_amdgcn_s_barrier()
#define PG8_SCHED __builtin_amdgcn_sched_barrier(0)
    Unit cur, nxt; int ui = 0;
    if (!S.next(0, cur)) return;
    f32x4 acc[2][2][4][2];
#pragma unroll
    for (int a = 0; a < 2; ++a)
#pragma unroll
        for (int b = 0; b < 2; ++b)
#pragma unroll
            for (int m = 0; m < 4; ++m)
#pragma unroll
                for (int n = 0; n < 2; ++n) acc[a][b][m][n] = (f32x4){0.f, 0.f, 0.f, 0.f};
    bf16x8 At[4][2], B0[2][2], B1[2][2];
    const char* cA = (const char*)g.A + (size_t)cur.pm * tstep; const char* cB = (const char*)g.Bt + (size_t)cur.pn * tstep;
    S.a_ready(cur);
    if constexpr (SP2) {
        PG8_STAGE(PG8_SB(0, 0), cB, voffB); PG8_STAGE(PG8_SB(0, 1), cB + hstep, voffB); PG8_STAGE(PG8_SA(0, 0), cA, voffA); PG8_STAGE(PG8_SA(0, 1), cA + hstep, voffA);
        if (wr == 1) PG8_BAR;
        PG8_WAIT_V(2); PG8_BAR;
        PG8_STAGE(PG8_SB(1, 0), cB + kstep, voffB); PG8_STAGE(PG8_SA(1, 0), cA + kstep, voffA); PG8_STAGE(PG8_SB(1, 1), cB + hstep + kstep, voffB);
        PG8_WAIT_V(6); PG8_BAR;
    } else {
        PG8_STAGE(PG8_SB(0, 0), cB, voffB); PG8_STAGE(PG8_SA(0, 0), cA, voffA); PG8_STAGE(PG8_SB(0, 1), cB + hstep, voffB); PG8_STAGE(PG8_SA(0, 1), cA + hstep, voffA);
        if (wr == 1) PG8_BAR;
        PG8_WAIT_V(4); PG8_BAR;
        PG8_STAGE(PG8_SB(1, 0), cB + kstep, voffB); PG8_STAGE(PG8_SA(1, 0), cA + kstep, voffA); PG8_STAGE(PG8_SB(1, 1), cB + hstep + kstep, voffB);
        PG8_WAIT_V(6); PG8_BAR;
    }
    for (;;) {
        const bool has_next = S.next(ui + 1, nxt);
        const char* nA = has_next ? (const char*)g.A + (size_t)nxt.pm * tstep : cA; const char* nB = has_next ? (const char*)g.Bt + (size_t)nxt.pn * tstep : cB;
        for (int t = 0; t < nt; t += 2) {
            const bool last = (t == nt - 2);
            const char* a1 = cA + (size_t)(t + 1) * kstep;
            const char* a2 = last ? nA : cA + (size_t)(t + 2) * kstep; const char* b2 = last ? nB : cB + (size_t)(t + 2) * kstep;
            const char* a3 = a2 + kstep; const char* b3 = b2 + kstep;
            if (last && has_next) S.a_ready(nxt);
            if constexpr (SP2) {
            PG8_LDB(B0, 0, 0); PG8_LDB(B1, 0, 1); PG8_SCHED; PG8_LDA(At, 0, 0); PG8_STAGE(PG8_SA(1, 1), a1 + hstep, voffA);
            PG8_WAIT_V(8); PG8_WAIT_L(0); PG8_BAR; PG8_MMA(0, 0, At, B0); PG8_MMA(0, 1, At, B1); PG8_BAR; PG8_SCHED;
            PG8_LDA(At, 0, 1); PG8_STAGE(PG8_SB(0, 0), b2, voffB); PG8_STAGE(PG8_SB(0, 1), b2 + hstep, voffB); PG8_STAGE(PG8_SA(0, 0), a2, voffA);
            PG8_WAIT_V(8); PG8_WAIT_L(0); PG8_BAR; PG8_MMA(1, 0, At, B0); PG8_MMA(1, 1, At, B1); PG8_BAR; PG8_SCHED;
            PG8_LDB(B0, 1, 0); PG8_LDB(B1, 1, 1); PG8_SCHED; PG8_LDA(At, 1, 0); PG8_STAGE(PG8_SA(0, 1), a2 + hstep, voffA);
            PG8_WAIT_V(8); PG8_WAIT_L(0); PG8_BAR; PG8_MMA(0, 0, At, B0); PG8_MMA(0, 1, At, B1); PG8_BAR; PG8_SCHED;
            PG8_LDA(At, 1, 1); PG8_STAGE(PG8_SB(1, 0), b3, voffB); PG8_STAGE(PG8_SB(1, 1), b3 + hstep, voffB); PG8_STAGE(PG8_SA(1, 0), a3, voffA);
            PG8_WAIT_V(8); PG8_WAIT_L(0); PG8_BAR; PG8_MMA(1, 0, At, B0); PG8_MMA(1, 1, At, B1); PG8_BAR; PG8_SCHED;
            } else {
            PG8_LDB(B0, 0, 0); PG8_SCHED; PG8_LDA(At, 0, 0); PG8_STAGE(PG8_SA(1, 1), a1 + hstep, voffA);
            PG8_WAIT_L(8); PG8_BAR; PG8_WAIT_L(0); PG8_MMA(0, 0, At, B0); PG8_BAR; PG8_SCHED;
            PG8_LDB(B1, 0, 1); PG8_STAGE(PG8_SB(0, 0), b2, voffB);
            PG8_BAR; PG8_WAIT_L(0); PG8_MMA(0, 1, At, B1); PG8_BAR;
            PG8_LDA(At, 0, 1); PG8_STAGE(PG8_SA(0, 0), a2, voffA);
            PG8_BAR; PG8_WAIT_L(0); PG8_MMA(1, 0, At, B0); PG8_BAR; PG8_SCHED;
            PG8_STAGE(PG8_SB(0, 1), b2 + hstep, voffB);
            PG8_WAIT_V(6); PG8_BAR; PG8_MMA(1, 1, At, B1); PG8_BAR;
            PG8_LDB(B0, 1, 0); PG8_SCHED; PG8_LDA(At, 1, 0); PG8_STAGE(PG8_SA(0, 1), a2 + hstep, voffA);
            PG8_WAIT_L(8); PG8_BAR; PG8_WAIT_L(0); PG8_MMA(0, 0, At, B0); PG8_BAR; PG8_SCHED;
            PG8_LDB(B1, 1, 1); PG8_STAGE(PG8_SB(1, 0), b3, voffB);
            PG8_BAR; PG8_WAIT_L(0); PG8_MMA(0, 1, At, B1); PG8_BAR;
            PG8_LDA(At, 1, 1); PG8_STAGE(PG8_SA(1, 0), a3, voffA);
            PG8_BAR; PG8_WAIT_L(0); PG8_MMA(1, 0, At, B0); PG8_BAR; PG8_SCHED;
            PG8_STAGE(PG8_SB(1, 1), b3 + hstep, voffB);
            PG8_WAIT_V(6); PG8_BAR; PG8_MMA(1, 1, At, B1); PG8_BAR;
            }
        }
        if constexpr (ALIGN_EPI) { if (wr == 0) PG8_BAR; }
        if constexpr (!Epi::AFTER_DRAIN) { E(acc, cur, wr, wc, fr, fq); S.done(cur); }
        if (!has_next) break;
#pragma unroll
        for (int a = 0; a < 2; ++a)
#pragma unroll
            for (int b = 0; b < 2; ++b)
#pragma unroll
                for (int m = 0; m < 4; ++m)
#pragma unroll
                    for (int n = 0; n < 2; ++n) acc[a][b][m][n] = (f32x4){0.f, 0.f, 0.f, 0.f};
        cur = nxt; cA = nA; cB = nB; ++ui;
        if constexpr (ALIGN_EPI) { if (wr == 1) PG8_BAR; }
    }
    PG8_WAIT_V(0);
    if constexpr (!ALIGN_EPI) { if (wr == 0) PG8_BAR; }
    PG8_BAR;
    if constexpr (Epi::AFTER_DRAIN) { E.fused(acc, cur, wr, wc, fr, fq, lds, wid, lane); S.done(cur); }
#undef PG8_SA
#undef PG8_SB
#undef PG8_STAGE
#undef PG8_LDA
#undef PG8_LDB
#undef PG8_MMA
#undef PG8_WAIT_V
#undef PG8_WAIT_L
#undef PG8_BAR
#undef PG8_SCHED
}
}

#ifndef PG8_SP2
#define PG8_SP2 true
#endif
#ifndef PG8_ALIGN
#define PG8_ALIGN true
#endif

#define GAS __attribute__((address_space(1)))
#define LAS __attribute__((address_space(3)))
typedef unsigned short bf16;
typedef unsigned v4u __attribute__((ext_vector_type(4)));
typedef float f32x4 __attribute__((ext_vector_type(4)));
typedef short bf16x8 __attribute__((ext_vector_type(8)));
typedef GAS unsigned gu32;
typedef GAS unsigned long long gu64;
#define RLX_AGENT __ATOMIC_RELAXED, __HIP_MEMORY_SCOPE_AGENT
#define LDS_WAIT() asm volatile("s_waitcnt lgkmcnt(0)" ::: "memory")
#define VM_WAIT() asm volatile("s_waitcnt vmcnt(0)" ::: "memory")
__device__ __forceinline__ unsigned long long rt() { return __builtin_amdgcn_s_memrealtime(); }
__device__ __forceinline__ unsigned f2bf(float f) { unsigned u = __builtin_bit_cast(unsigned, f); return (u + 0x7fffu + ((u >> 16) & 1u)) >> 16; }
__device__ __forceinline__ unsigned pk2(float lo, float hi) { return f2bf(lo) | (f2bf(hi) << 16); }

#define XB_TMO      128
#define XB_XCNT(j)  (256  + 64 * (j))
#define XB_XSUB(j)  (1280 + 64 * (j))
#define XB_XGEN(j)  (2304 + 64 * (j))
#define XB_TOP      3328
#define XB_TOPGEN   3392
#define XCD_BAR_WORDS 3456
#define XB_SPIN_CAP (1u << 18)

__device__ __forceinline__ unsigned xb_ld(unsigned* p)              { return __hip_atomic_load(p, __ATOMIC_RELAXED, __HIP_MEMORY_SCOPE_AGENT); }
__device__ __forceinline__ unsigned xb_add(unsigned* p, unsigned v) { return __hip_atomic_fetch_add(p, v, __ATOMIC_RELAXED, __HIP_MEMORY_SCOPE_AGENT); }
__device__ __forceinline__ unsigned xb_xcc_id() { return (unsigned)__builtin_amdgcn_s_getreg((3 << 11) | 20) & 0xFu; }
#define XB_SPIN(cond, bar) do { unsigned _sp = 0; while (cond) { __builtin_amdgcn_s_sleep(1); \
    if ((++_sp & 255u) == 0u) { if (xb_ld(&(bar)[XB_TMO])) break; if (_sp > XB_SPIN_CAP) { atomicAdd(&(bar)[XB_TMO], 1u); break; } } } } while (0)

struct XcdBarrier {
    unsigned* bar; unsigned x;
    volatile LAS unsigned* st;
};

__device__ __forceinline__ XcdBarrier xcd_barrier_post(unsigned* bar, volatile LAS unsigned* st) {
    XcdBarrier b; b.bar = bar; b.x = xb_xcc_id(); b.st = st;
    if (threadIdx.x == 0) (void)xb_add(&bar[XB_XCNT(b.x)], 1u);
    return b;
}
__device__ __forceinline__ void xcd_barrier_complete(unsigned* bar, unsigned x, unsigned& nloc, unsigned& nx) {
    const unsigned G = gridDim.x * gridDim.y * gridDim.z;
    unsigned sum, cnt, mine, sp = 0u;
    for (;;) {
        sum = 0u; cnt = 0u; mine = 0u;
#pragma unroll
        for (unsigned j = 0; j < 16; ++j) { const unsigned c = xb_ld(&bar[XB_XCNT(j)]); sum += c; cnt += (c > 0u) ? 1u : 0u; mine = (j == x) ? c : mine; }
        if (sum == G) break;
        __builtin_amdgcn_s_sleep(1);
        if ((++sp & 255u) == 0u) { if (xb_ld(&bar[XB_TMO])) break; if (sp > XB_SPIN_CAP) { atomicAdd(&bar[XB_TMO], 1u); break; } }
    }
    nloc = mine > 0u ? mine : 1u; nx = cnt > 0u ? cnt : 1u;
}

__device__ __forceinline__ void xcd_barrier(const XcdBarrier& b) {
    asm volatile("s_waitcnt vmcnt(0)" ::: "memory");
    __syncthreads();
    if (threadIdx.x == 0) {
        unsigned* bar = b.bar;
        __builtin_amdgcn_s_waitcnt(0);
        unsigned nloc = b.st[0], nx = b.st[1];
        if (nloc == 0u) { xcd_barrier_complete(bar, b.x, nloc, nx); b.st[0] = nloc; b.st[1] = nx; }
        const unsigned old = xb_add(&bar[XB_XSUB(b.x)], 1u);
        const unsigned gen = old / nloc;
        if (old + 1u == (gen + 1u) * nloc) {
            __builtin_amdgcn_fence(__ATOMIC_RELEASE, "agent");
            asm volatile("s_waitcnt vmcnt(0)" ::: "memory");
            const unsigned og = xb_add(&bar[XB_TOP], 1u);
            const unsigned tg = og / nx;
            if (og + 1u == (tg + 1u) * nx) xb_add(&bar[XB_TOPGEN], 1u);
            else XB_SPIN(xb_ld(&bar[XB_TOPGEN]) == tg, bar);
            __builtin_amdgcn_fence(__ATOMIC_ACQUIRE, "agent");
            xb_add(&bar[XB_XGEN(b.x)], 1u);
            asm volatile("s_waitcnt vmcnt(0)" ::: "memory");
        } else {
            XB_SPIN(xb_ld(&bar[XB_XGEN(b.x)]) == gen, bar);
            __builtin_amdgcn_fence(__ATOMIC_ACQUIRE, "agent");
            asm volatile("s_waitcnt vmcnt(0)" ::: "memory");
        }
    }
    __syncthreads();
}

constexpr int NWAVES = 8, NTHR = 512;
constexpr int DM = 2048, NTOK = 8192, SEQ = 4096;
constexpr int DS5 = 1024, NGRP = 64, GH = 16, NST = 64;
constexpr int NHEAD = 4, GDK = 512, GDV = 1024, HK = 128, HV = 256, RANK = 16, CHUNK = 64, NCHUNK = 64;
constexpr int DIN = 5136, DINP = 5376;
constexpr float EPS = 1e-6f;
enum { I_X = 0, I_PREW, I_WIN, I_ARE, I_AIM, I_BRE, I_BIM, I_CRE, I_CIM, I_D, I_LOGDT, I_GLUW, I_GLUB, I_GUP, I_GBIAS, I_GNORM, I_WOUT, I_POSTW, N_IN };

constexpr size_t MiB = 1u << 20;
constexpr size_t WS_CTL = 0, CTL_ZERO_BYTES = 65536;
constexpr size_t WS_WIN = 1 * MiB;
constexpr size_t WS_WGLU = 22 * MiB;
constexpr size_t WS_WOUT = 24 * MiB;
constexpr size_t WS_XN = 32 * MiB;
constexpr size_t WS_KVT = 32 * MiB;
constexpr size_t WS_CONCAT = 32 * MiB;
constexpr size_t WS_UT = 64 * MiB;
constexpr size_t WS_ZS5 = 80 * MiB;
constexpr size_t WS_MIXED = 64 * MiB;
constexpr size_t WS_Q = 96 * MiB;
constexpr size_t WS_K = 104 * MiB;
constexpr size_t WS_V = 112 * MiB;
constexpr size_t WS_ZGLA = 128 * MiB;
constexpr size_t WS_GLOW = 144 * MiB;
constexpr size_t WS_DEC = 145 * MiB;
constexpr size_t WS_SLOC = 146 * MiB;
constexpr size_t WS_KT = 150 * MiB;
constexpr size_t WS_AT = 153 * MiB;
constexpr size_t WS_W1 = 154 * MiB;
constexpr size_t WS_W2 = 170 * MiB;
constexpr size_t WS_YPRE = 186 * MiB;
constexpr size_t WS_SPT = 202 * MiB;
constexpr size_t WS_END = 234 * MiB;
constexpr int CW_BAR = 4096;

constexpr int RING_OFF = 0, RING_BYTES = 131072;
constexpr int LDSCTL_OFF = RING_BYTES, MISC_OFF = LDSCTL_OFF + 320;
constexpr int LDS_BYTES = 147456;

struct Args { const float* in[N_IN]; float* out; unsigned char* ws; int ph_lo, ph_hi; };
static_assert(sizeof(Args) == N_IN * 8 + 8 + 8 + 8, "Args has no padding");

struct Frame {
    LAS unsigned char* lds; volatile LAS unsigned* MISC; gu32* ctl;
    int tid, lane, wave, vcu, G;
};

__device__ __forceinline__ float wave_sum(float v) {
#pragma unroll
    for (int o = 1; o < 64; o <<= 1) v += __shfl_xor(v, o);
    return v;
}
__device__ __forceinline__ float bf2f(unsigned short b) { return __builtin_bit_cast(float, ((unsigned)b) << 16); }
__device__ __forceinline__ void store8bf(bf16* p, const float (&v)[8]) {
    v4u w; w.x = pg8::cvt_pk_bf16(v[0], v[1]); w.y = pg8::cvt_pk_bf16(v[2], v[3]); w.z = pg8::cvt_pk_bf16(v[4], v[5]); w.w = pg8::cvt_pk_bf16(v[6], v[7]);
    *(v4u*)p = w;
}
__device__ __forceinline__ void load8bf(const bf16* p, float (&v)[8]) {
    const v4u w = *(const v4u*)p;
    v[0] = __builtin_bit_cast(float, w.x << 16); v[1] = __builtin_bit_cast(float, w.x & 0xffff0000u);
    v[2] = __builtin_bit_cast(float, w.y << 16); v[3] = __builtin_bit_cast(float, w.y & 0xffff0000u);
    v[4] = __builtin_bit_cast(float, w.z << 16); v[5] = __builtin_bit_cast(float, w.z & 0xffff0000u);
    v[6] = __builtin_bit_cast(float, w.w << 16); v[7] = __builtin_bit_cast(float, w.w & 0xffff0000u);
}
__device__ __forceinline__ float sigmoidf_(float x) { return 1.0f / (1.0f + __expf(-x)); }
__device__ __forceinline__ float siluf_(float x) { return x * sigmoidf_(x); }
__device__ __forceinline__ float gelu_tanh(float x) {
    const float z = 0.7978845608028654f * (x + 0.044715f * x * x * x);
    const float t = 1.0f - 2.0f / (1.0f + __expf(2.0f * z));
    return 0.5f * x * (1.0f + t);
}
__device__ __forceinline__ float log_sigmoid(float z) { return fminf(z, 0.f) - log1pf(__expf(-fabsf(z))); }
__device__ __forceinline__ void cexp_dt(float ar, float ai, float dt, float mult, float& re, float& im) {
    const double th = (double)ai * (double)dt * (double)mult;
    const double k = __builtin_rint(th * 0.15915494309189535);
    const float r = (float)(th - k * 6.283185307179586);
    const float mag = expf(ar * dt * mult);
    re = mag * cosf(r); im = mag * sinf(r);
}

struct ProjSink {
    bf16 *UT, *ZS5, *Q, *K, *V, *ZGLA; float* GLOW;
    __device__ __forceinline__ void operator()(int row, int c0, const float (&v)[8]) const {
        if (c0 < 1024) { const int g = c0 >> 4; store8bf(UT + ((size_t)g * NTOK + row) * 16 + (c0 & 15), v); }
        else if (c0 < 2048) { float o[8];
#pragma unroll
            for (int i = 0; i < 8; ++i) o[i] = siluf_(v[i]);
            store8bf(ZS5 + (size_t)row * 1024 + (c0 - 1024), o); }
        else if (c0 < 2560) { float o[8];
#pragma unroll
            for (int i = 0; i < 8; ++i) o[i] = v[i] * 0.08838834764831845f;
            store8bf(Q + (size_t)row * 512 + (c0 - 2048), o); }
        else if (c0 < 3072) store8bf(K + (size_t)row * 512 + (c0 - 2560), v);
        else if (c0 < 4096) store8bf(V + (size_t)row * 1024 + (c0 - 3072), v);
        else if (c0 < 5120) { float o[8];
#pragma unroll
            for (int i = 0; i < 8; ++i) o[i] = siluf_(v[i]);
            store8bf(ZGLA + (size_t)row * 1024 + (c0 - 4096), o); }
        else if (c0 < DIN) { float* p = GLOW + (size_t)row * 16 + (c0 - 5120);
            *(f32x4*)p = (f32x4){v[0], v[1], v[2], v[3]}; *(f32x4*)(p + 4) = (f32x4){v[4], v[5], v[6], v[7]}; }
    }
};
struct GluSink {
    const bf16 *YPRE, *ZS5; const float* glub; bf16* CONCAT;
    __device__ __forceinline__ void operator()(int row, int c0, const float (&v)[8]) const {
        float y[8], g[8], o[8]; load8bf(YPRE + (size_t)row * 1024 + c0, y); load8bf(ZS5 + (size_t)row * 1024 + c0, g);
        const f32x4 b0 = *(const f32x4*)(glub + c0), b1 = *(const f32x4*)(glub + c0 + 4);
        const float b[8] = {b0[0], b0[1], b0[2], b0[3], b1[0], b1[1], b1[2], b1[3]};
#pragma unroll
        for (int i = 0; i < 8; ++i) o[i] = y[i] * sigmoidf_(v[i] + b[i]) * g[i];
        store8bf(CONCAT + (size_t)row * 2048 + c0, o);
    }
};
struct MixSink {
    bf16* MIXED;
    __device__ __forceinline__ void operator()(int row, int c0, const float (&v)[8]) const { store8bf(MIXED + (size_t)row * 2048 + c0, v); }
};

template <class Sink> __device__ __forceinline__ void naive_gemm(const bf16* A, const bf16* Bt, int M, int N, int K, const Sink& s, int gtid, int gthreads) {
    const int n8 = N / 8; const long total = (long)M * n8;
    for (long it = gtid; it < total; it += gthreads) {
        const int c0 = (int)(it % n8) * 8, row = (int)(it / n8);
        float acc[8] = {0.f, 0.f, 0.f, 0.f, 0.f, 0.f, 0.f, 0.f};
        for (int k = 0; k < K; k += 8) {
            float a[8]; load8bf(A + (size_t)row * K + k, a);
#pragma unroll
            for (int i = 0; i < 8; ++i) { float b[8]; load8bf(Bt + (size_t)(c0 + i) * K + k, b);
#pragma unroll
                for (int j = 0; j < 8; ++j) acc[i] += a[j] * b[j]; }
        }
        s(row, c0, acc);
    }
}

__device__ __forceinline__ void p0_transpose_item(const float* W, int K, int N, int Npad, bf16* WT, LAS float* scr, int item, int lane) {
    const int nblk = Npad / 32, kb = item / nblk, nb = item % nblk, k0 = 64 * kb, n0 = 32 * nb;
    const int nl = n0 + (lane & 31); const bool ok = nl < N;
#pragma unroll 8
    for (int i = 0; i < 32; ++i) { const int kk = 2 * i + (lane >> 5); scr[kk * 33 + (lane & 31)] = ok ? W[(size_t)(k0 + kk) * N + nl] : 0.f; }
    LDS_WAIT(); asm volatile("" ::: "memory");
    const int c = lane & 7;
#pragma unroll
    for (int j = 0; j < 4; ++j) { const int n = (lane >> 3) + 8 * j; const LAS float* s = scr + (8 * c) * 33 + n;
        v4u o; o.x = pg8::cvt_pk_bf16(s[0 * 33], s[1 * 33]); o.y = pg8::cvt_pk_bf16(s[2 * 33], s[3 * 33]); o.z = pg8::cvt_pk_bf16(s[4 * 33], s[5 * 33]); o.w = pg8::cvt_pk_bf16(s[6 * 33], s[7 * 33]);
        *(v4u*)(WT + (size_t)(n0 + n) * K + k0 + 8 * c) = o; }
    LDS_WAIT(); asm volatile("" ::: "memory");
}
__device__ __forceinline__ void p0_xn_row(const float* xrow, const float* w, bf16* orow, int lane) {
    const f32x4* xr = (const f32x4*)xrow + lane; const f32x4* wr = (const f32x4*)w + lane;
    f32x4 v[8]; float s = 0.f;
#pragma unroll
    for (int j = 0; j < 8; ++j) { v[j] = xr[64 * j]; s += (v[j].x * v[j].x + v[j].y * v[j].y) + (v[j].z * v[j].z + v[j].w * v[j].w); }
    const float rstd = 1.0f / sqrtf(wave_sum(s) * (1.0f / DM) + EPS);
    unsigned long long* o8 = (unsigned long long*)orow + lane;
#pragma unroll
    for (int j = 0; j < 8; ++j) { const f32x4 wv = wr[64 * j]; const f32x4 o = v[j] * rstd * wv;
        o8[64 * j] = (unsigned long long)pg8::cvt_pk_bf16(o.x, o.y) | ((unsigned long long)pg8::cvt_pk_bf16(o.z, o.w) << 32); }
}
__device__ __forceinline__ void p0_prologue(const Frame& F, const Args& a) {
    LAS float* scr = (LAS float*)(F.lds + RING_OFF + F.wave * 16384);
    const int gw = F.vcu * NWAVES + F.wave, NGW = F.G * NWAVES;
    constexpr int I_IN = (DM / 64) * (DINP / 32), I_GLU = (DS5 / 64) * (DS5 / 32), I_OUT = (DM / 64) * (DM / 32);
    constexpr int NITEMS = I_IN + I_GLU + I_OUT;
    for (int it = gw; it < NITEMS; it += NGW) {
        int r = it;
        if (r < I_IN) { p0_transpose_item(a.in[I_WIN], DM, DIN, DINP, (bf16*)(a.ws + WS_WIN), scr, r, F.lane); continue; } r -= I_IN;
        if (r < I_GLU) { p0_transpose_item(a.in[I_GLUW], DS5, DS5, DS5, (bf16*)(a.ws + WS_WGLU), scr, r, F.lane); continue; } r -= I_GLU;
        p0_transpose_item(a.in[I_WOUT], DM, DM, DM, (bf16*)(a.ws + WS_WOUT), scr, r, F.lane);
    }
    for (int m = gw; m < NTOK; m += NGW) p0_xn_row(a.in[I_X] + (size_t)m * DM, a.in[I_PREW], (bf16*)(a.ws + WS_XN) + (size_t)m * DM, F.lane);
}

__device__ __forceinline__ void s5_naive_item(const Args& a, int item, int lane) {
    const int b = item / NGRP, g = item % NGRP, p = lane;
    const float ar = fminf(a.in[I_ARE][g * NST + p], -1e-4f), ai = a.in[I_AIM][g * NST + p];
    const float dt = expf(a.in[I_LOGDT][g]);
    float abr, abi; cexp_dt(ar, ai, dt, 1.0f, abr, abi);
    const float xr = abr - 1.0f, xi = abi, den = 1.0f / (ar * ar + ai * ai);
    const float cr = (xr * ar + xi * ai) * den, ci = (xi * ar - xr * ai) * den;
    float Bbr[GH], Bbi[GH], Ccr[GH], Cci[GH], Dv[GH];
#pragma unroll
    for (int h = 0; h < GH; ++h) {
        const float br = a.in[I_BRE][(g * NST + p) * GH + h], bi = a.in[I_BIM][(g * NST + p) * GH + h];
        Bbr[h] = cr * br - ci * bi; Bbi[h] = cr * bi + ci * br;
        Ccr[h] = a.in[I_CRE][(g * GH + h) * NST + p]; Cci[h] = a.in[I_CIM][(g * GH + h) * NST + p];
        Dv[h] = a.in[I_D][g * GH + h];
    }
    const bf16* U = (const bf16*)(a.ws + WS_UT) + ((size_t)g * NTOK + (size_t)b * SEQ) * 16;
    bf16* Y = (bf16*)(a.ws + WS_YPRE) + (size_t)b * SEQ * DS5 + g * GH;
    float sr = 0.f, si = 0.f;
    for (int t = 0; t < SEQ; ++t) {
        float u[16]; { float u0[8], u1[8]; load8bf(U + (size_t)t * 16, u0); load8bf(U + (size_t)t * 16 + 8, u1);
#pragma unroll
            for (int i = 0; i < 8; ++i) { u[i] = u0[i]; u[8 + i] = u1[i]; } }
        float bur = 0.f, bui = 0.f;
#pragma unroll
        for (int h = 0; h < GH; ++h) { bur += Bbr[h] * u[h]; bui += Bbi[h] * u[h]; }
        const float nr = abr * sr - abi * si + bur, ni = abr * si + abi * sr + bui; sr = nr; si = ni;
        float mine = 0.f;
#pragma unroll
        for (int h = 0; h < GH; ++h) { const float y = wave_sum(Ccr[h] * sr - Cci[h] * si) + Dv[h] * u[h]; mine = (lane == h) ? y : mine; }
        if (lane < GH) { const float o = gelu_tanh(mine); Y[(size_t)t * DS5 + lane] = (bf16)(pg8::cvt_pk_bf16(o, 0.f) & 0xffffu); }
    }
}

__device__ __forceinline__ void gla_naive_item(const Frame& F, const Args& a, int item) {
    const int b = item / NHEAD, h = item % NHEAD, tid = F.tid, dv = tid & 255, half = tid >> 8;
    LAS float* qs = (LAS float*)(F.lds + RING_OFF); LAS float* ks = qs + 128; LAS float* gs = ks + 128; LAS float* part = gs + 128; LAS float* red = part + 512;
    float S[64];
#pragma unroll
    for (int j = 0; j < 64; ++j) S[j] = 0.f;
    float gu[RANK]; float gb = 0.f;
    if (tid < HK) {
#pragma unroll
        for (int r = 0; r < RANK; ++r) gu[r] = a.in[I_GUP][r * GDK + h * HK + tid];
        gb = a.in[I_GBIAS][h * HK + tid];
    } else {
#pragma unroll
        for (int r = 0; r < RANK; ++r) gu[r] = 0.f;
    }
    const float nw = a.in[I_GNORM][dv];
    const bf16* Q = (const bf16*)(a.ws + WS_Q); const bf16* K = (const bf16*)(a.ws + WS_K); const bf16* V = (const bf16*)(a.ws + WS_V);
    const bf16* ZG = (const bf16*)(a.ws + WS_ZGLA); const float* GL = (const float*)(a.ws + WS_GLOW); bf16* CC = (bf16*)(a.ws + WS_CONCAT);
    for (int t = 0; t < SEQ; ++t) {
        const size_t tok = (size_t)b * SEQ + t;
        if (tid < HK) {
            float z = gb;
#pragma unroll
            for (int r = 0; r < RANK; ++r) z += GL[tok * 16 + r] * gu[r];
            gs[tid] = __expf(log_sigmoid(z) * (1.0f / 16.0f));
            qs[tid] = bf2f(Q[tok * GDK + h * HK + tid]); ks[tid] = bf2f(K[tok * GDK + h * HK + tid]);
        }
        __syncthreads();
        const float v = bf2f(V[tok * GDV + h * HV + dv]);
        float o = 0.f;
#pragma unroll
        for (int j = 0; j < 64; ++j) { const int dk = half * 64 + j; S[j] = gs[dk] * S[j] + ks[dk] * v; o += qs[dk] * S[j]; }
        part[tid] = o;
        __syncthreads();
        float ot = 0.f;
        if (half == 0) { ot = part[dv] + part[256 + dv]; const float ss = wave_sum(ot * ot); if (F.lane == 0) red[F.wave] = ss; }
        __syncthreads();
        if (half == 0) { const float tot = (red[0] + red[1]) + (red[2] + red[3]); const float rstd = 1.0f / sqrtf(tot * (1.0f / HV) + EPS);
            const float res = ot * rstd * nw * bf2f(ZG[tok * GDV + h * HV + dv]);
            CC[tok * 2048 + 1024 + h * HV + dv] = (bf16)(pg8::cvt_pk_bf16(res, 0.f) & 0xffffu); }
        __syncthreads();
    }
}

__device__ __forceinline__ void p6_row(const float* xrow, const bf16* mrow, const float* pw, float* orow, int lane) {
    float m[4][8]; float s = 0.f;
#pragma unroll
    for (int j = 0; j < 4; ++j) { load8bf(mrow + (size_t)(lane + 64 * j) * 8, m[j]);
#pragma unroll
        for (int i = 0; i < 8; ++i) s += m[j][i] * m[j][i]; }
    const float rstd = 1.0f / sqrtf(wave_sum(s) * (1.0f / DM) + EPS);
#pragma unroll
    for (int j = 0; j < 4; ++j) { const int c = (lane + 64 * j) * 8;
#pragma unroll
        for (int q = 0; q < 2; ++q) { const f32x4 xv = *(const f32x4*)(xrow + c + 4 * q), wv = *(const f32x4*)(pw + c + 4 * q);
            const f32x4 mv = (f32x4){m[j][4 * q], m[j][4 * q + 1], m[j][4 * q + 2], m[j][4 * q + 3]};
            *(f32x4*)(orow + c + 4 * q) = xv + mv * rstd * wv; } }
}

constexpr int NPHASE = 7;
__global__ void __launch_bounds__(NTHR, 2) mega_fwd(Args a) {
    extern __shared__ __attribute__((aligned(16))) unsigned char lds[];
    Frame F;
    F.lds = (LAS unsigned char*)lds; F.MISC = (volatile LAS unsigned*)(F.lds + MISC_OFF);
    F.tid = threadIdx.x; F.lane = F.tid & 63; F.wave = __builtin_amdgcn_readfirstlane(F.tid >> 6);
    F.G = gridDim.x; { const int bx = blockIdx.x; F.vcu = (F.G % 8 == 0) ? (bx % 8) * (F.G / 8) + bx / 8 : bx; }
    F.ctl = (gu32*)(a.ws + WS_CTL);
    for (int u = F.tid; u < (LDS_BYTES - LDSCTL_OFF) / 4; u += NTHR) ((LAS unsigned*)(F.lds + LDSCTL_OFF))[u] = 0u;
    __syncthreads();
    const int lo = a.ph_lo, hi = a.ph_hi;
    const bool use_bar = (hi - lo) > 1;
    XcdBarrier bar; bar.bar = (unsigned*)(F.ctl + CW_BAR); bar.x = 0; bar.st = nullptr;
    if (use_bar) bar = xcd_barrier_post((unsigned*)(F.ctl + CW_BAR), F.MISC + 8);
#define IN(k) (lo <= (k) && (k) < hi)
#define SEAM(k) do { if (IN(k) && IN((k) + 1)) xcd_barrier(bar); } while (0)
    const int gtid = blockIdx.x * NTHR + F.tid, gthreads = F.G * NTHR;
    const int gw = blockIdx.x * NWAVES + F.wave, NGW = F.G * NWAVES;
    unsigned char* ws = a.ws;

    if (IN(0)) { p0_prologue(F, a); }
    SEAM(0);

    if (IN(1)) {
        ProjSink ps{(bf16*)(ws + WS_UT), (bf16*)(ws + WS_ZS5), (bf16*)(ws + WS_Q), (bf16*)(ws + WS_K), (bf16*)(ws + WS_V), (bf16*)(ws + WS_ZGLA), (float*)(ws + WS_GLOW)};
#if FAST_GEMM
        pg8::Gemm g{(const pg8::bf16_t*)(ws + WS_XN), (const pg8::bf16_t*)(ws + WS_WIN), NTOK, DINP, DM}; pg8::StaticOrder S; S.init(NTOK, DINP, F.G, (int)blockIdx.x);
        pg8::Epi8<ProjSink> E{ps};
        pg8::gemm_phase<pg8::Epi8<ProjSink>, pg8::StaticOrder, PG8_ALIGN, PG8_SP2>(F.lds + RING_OFF, g, S, E);
#else
        naive_gemm((const bf16*)(ws + WS_XN), (const bf16*)(ws + WS_WIN), NTOK, DINP, DM, ps, gtid, gthreads);
#endif
    }
    SEAM(1);

    if (IN(2)) { }
    SEAM(2);

    if (IN(3)) {
#if !FAST_GLA
        if (blockIdx.x < 8) gla_naive_item(F, a, (int)blockIdx.x);
#endif
#if !FAST_S5
        if (blockIdx.x >= 8 && blockIdx.x < 8 + 16) s5_naive_item(a, ((int)blockIdx.x - 8) * NWAVES + F.wave, F.lane);
#endif
    }
    SEAM(3);

    if (IN(4)) {
        GluSink gs{(const bf16*)(ws + WS_YPRE), (const bf16*)(ws + WS_ZS5), a.in[I_GLUB], (bf16*)(ws + WS_CONCAT)};
#if FAST_GEMM
        pg8::Gemm g{(const pg8::bf16_t*)(ws + WS_YPRE), (const pg8::bf16_t*)(ws + WS_WGLU), NTOK, DS5, DS5}; pg8::StaticOrder S; S.init(NTOK, DS5, F.G, (int)blockIdx.x);
        pg8::Epi8<GluSink> E{gs};
        pg8::gemm_phase<pg8::Epi8<GluSink>, pg8::StaticOrder, PG8_ALIGN, PG8_SP2>(F.lds + RING_OFF, g, S, E);
#else
        naive_gemm((const bf16*)(ws + WS_YPRE), (const bf16*)(ws + WS_WGLU), NTOK, DS5, DS5, gs, gtid, gthreads);
#endif
    }
    SEAM(4);

    if (IN(5)) {
        MixSink ms{(bf16*)(ws + WS_MIXED)};
#if FAST_GEMM
        pg8::Gemm g{(const pg8::bf16_t*)(ws + WS_CONCAT), (const pg8::bf16_t*)(ws + WS_WOUT), NTOK, DM, DM}; pg8::StaticOrder S; S.init(NTOK, DM, F.G, (int)blockIdx.x);
        pg8::Epi8<MixSink> E{ms};
        pg8::gemm_phase<pg8::Epi8<MixSink>, pg8::StaticOrder, PG8_ALIGN, PG8_SP2>(F.lds + RING_OFF, g, S, E);
#else
        naive_gemm((const bf16*)(ws + WS_CONCAT), (const bf16*)(ws + WS_WOUT), NTOK, DM, DM, ms, gtid, gthreads);
#endif
    }
    SEAM(5);

    if (IN(6)) {
        for (int m = gw; m < NTOK; m += NGW) p6_row(a.in[I_X] + (size_t)m * DM, (const bf16*)(ws + WS_MIXED) + (size_t)m * DM, a.in[I_POSTW], a.out + (size_t)m * DM, F.lane);
    }
#undef IN
#undef SEAM
}

extern "C" void kernel_launch(void* const* d_in, const int* in_sizes, int n_in, void* d_out, int out_size, void* d_ws, size_t ws_size, hipStream_t stream) {
    static int grid = 0;
    if (grid == 0) {
        if (n_in != N_IN || out_size != NTOK * DM || ws_size < WS_END) { fprintf(stderr, "kernel_launch: unexpected problem shape (n_in %d out %d ws %zu)\n", n_in, out_size, ws_size); grid = -1; return; }
        int dev = 0, cus = 0;
        if (hipGetDevice(&dev) != hipSuccess || hipDeviceGetAttribute(&cus, hipDeviceAttributeMultiprocessorCount, dev) != hipSuccess) { grid = -1; return; }
        if (hipFuncSetAttribute((const void*)mega_fwd, hipFuncAttributeMaxDynamicSharedMemorySize, LDS_BYTES) != hipSuccess) { fprintf(stderr, "kernel_launch: hipFuncSetAttribute failed\n"); grid = -1; return; }
        grid = cus;
    }
    if (grid < 0) return;
    (void)hipMemsetAsync((char*)d_ws + WS_CTL, 0, CTL_ZERO_BYTES, stream);
    Args a{};
    for (int i = 0; i < N_IN; ++i) a.in[i] = (const float*)d_in[i];
    a.out = (float*)d_out; a.ws = (unsigned char*)d_ws;
#if MK_ONE_LAUNCH
    a.ph_lo = 0; a.ph_hi = NPHASE;
    hipLaunchKernelGGL(mega_fwd, dim3(grid), dim3(NTHR), LDS_BYTES, stream, a);
#else
    for (int p = 0; p < NPHASE; ++p) {
        if (p == 2 && !(FAST_S5 || FAST_GLA)) continue;
        a.ph_lo = p; a.ph_hi = p + 1;
        hipLaunchKernelGGL(mega_fwd, dim3(grid), dim3(NTHR), LDS_BYTES, stream, a);
    }
#endif
}
```

```cpp
#include <hip/hip_runtime.h>
#include <cstdio>
#include <cstdint>

#define MK_ONE_LAUNCH 1
#define FAST_GEMM 1
#define FAST_S5 0
#define FAST_GLA 0

namespace pg8 {
#define PG8_LAS __attribute__((address_space(3)))
typedef unsigned short bf16_t;
typedef short bf16x8 __attribute__((ext_vector_type(8)));
typedef float f32x4 __attribute__((ext_vector_type(4)));
typedef unsigned u32x4 __attribute__((ext_vector_type(4)));
constexpr int BM = 256, BK = 64, HALF = 128, HTB = HALF * BK * 2  , STAGE_BYTES = 8 * HTB, NXCD = 8, WGM = 8;

__host__ __device__ __forceinline__ int lds_byte(int r, int c) { const int st = (r >> 4) * 2 + (c >> 5), rr = r & 15, cc = c & 31, ob = rr * 64 + cc * 2; return st * 1024 + (ob ^ (((ob >> 9) & 1) << 5)); }
__host__ __device__ __forceinline__ void stage_rc(int b, int& R, int& C) { const int st = b / 1024, sb = b % 1024, swz = sb ^ (((sb >> 9) & 1) << 5); R = (st >> 1) * 16 + swz / 64; C = (st & 1) * 32 + (swz % 64) / 2; }
__host__ __device__ __forceinline__ int perm32(int rho) { const int n = rho >> 4, i = rho & 15; return 8 * (i >> 2) + 4 * n + (i & 3); }

struct Unit { int pm, pn; };
struct Gemm { const bf16_t* A; const bf16_t* Bt; int M, N, K; };

struct StaticOrder {
    int nM, nN, nwg, G, c;
    __host__ __device__ void init(int M, int N, int G_, int c_) { nM = M / BM; nN = N / BM; nwg = nM * nN; G = G_; c = c_; }
    __host__ __device__ bool next(int i, Unit& u) const {
        const long L = (long)i * G + c; if (L >= nwg) return false;
        int wgid = (int)L; { const int q = nwg / NXCD, r = nwg % NXCD, xcd = wgid % NXCD, off = wgid / NXCD; wgid = (xcd < r ? xcd * (q + 1) : r * (q + 1) + (xcd - r) * q) + off; }
        const int nig = WGM * nN, gid = wgid / nig, fm = gid * WGM, gsz = (nM - fm) < WGM ? (nM - fm) : WGM;
        u.pm = fm + ((wgid % nig) % gsz); u.pn = (wgid % nig) / gsz; return true;
    }
    __device__ __forceinline__ void a_ready(const Unit&) const {}
    __device__ __forceinline__ void done(const Unit&) const {}
};

__device__ __forceinline__ unsigned cvt_pk_bf16(float lo, float hi) { unsigned r; asm volatile("v_cvt_pk_bf16_f32 %0, %1, %2" : "=v"(r) : "v"(lo), "v"(hi)); return r; }
typedef float f32x2 __attribute__((ext_vector_type(2)));
__device__ __forceinline__ f32x2 gelu_pk(f32x2 v) {
    const f32x2 av = __builtin_elementwise_abs(v), d = av * 0.2316418882f + 1.0f;
    f32x2 t; t.x = __builtin_amdgcn_rcpf(d.x); t.y = __builtin_amdgcn_rcpf(d.y);
    f32x2 q = t * 0.5307027145f + (-0.7265760135f); q = q * t + 0.7107068705f; q = q * t + (-0.142248368f); q = q * t + 0.127414796f; q = q * t;
    const f32x2 s = (v * v) * (-0.72134752044f);
    f32x2 e; e.x = __builtin_amdgcn_exp2f(s.x); e.y = __builtin_amdgcn_exp2f(s.y);
    const f32x2 m = v * (q * e), r = v - m;
    f32x2 o; o.x = v.x < 0.f ? m.x : r.x; o.y = v.y < 0.f ? m.y : r.y; return o;
}

template <int ACT  > struct EpiBf16 {
    static constexpr bool PERM = true, AFTER_DRAIN = false; static_assert(ACT == 0 || ACT == 1, "EpiBf16: ACT is 0 (none) or 1 (gelu_pk)");
    bf16_t* O; int ldc; const float* bias; int split_cols; size_t split_stride; float scale0;
    __device__ __forceinline__ void operator()(const f32x4 (&acc)[2][2][4][2], const Unit& u, int wr, int wc, int fr, int fq) const {
        const int row0 = u.pm * BM + wr * 64 + fr; int colt = u.pn * BM; bf16_t* base = O;
        float sc = 1.f; if (split_cols) { const int t = colt / split_cols; base += (size_t)t * split_stride; colt -= t * split_cols; if (t == 0) sc = scale0; }
        const int col0 = colt + wc * 32 + 8 * fq, bcol0 = u.pn * BM + wc * 32 + 8 * fq;
        f32x4 bv[2][2];
#pragma unroll
        for (int bj = 0; bj < 2; ++bj)
#pragma unroll
            for (int n = 0; n < 2; ++n) bv[bj][n] = bias ? *(const f32x4*)(bias + bcol0 + bj * HALF + 4 * n) : (f32x4){0.f, 0.f, 0.f, 0.f};
#pragma unroll
        for (int ai = 0; ai < 2; ++ai)
#pragma unroll
            for (int m = 0; m < 4; ++m) { bf16_t* rowp = base + (size_t)(row0 + ai * HALF + m * 16) * ldc + col0;
#pragma unroll
                for (int bj = 0; bj < 2; ++bj) { f32x4 v0 = acc[ai][bj][m][0] + bv[bj][0], v1 = acc[ai][bj][m][1] + bv[bj][1];
                    if (ACT == 1) { f32x2 a = gelu_pk((f32x2){v0[0], v0[1]}), b = gelu_pk((f32x2){v0[2], v0[3]}), c = gelu_pk((f32x2){v1[0], v1[1]}), d = gelu_pk((f32x2){v1[2], v1[3]});
                        v0 = (f32x4){a.x, a.y, b.x, b.y}; v1 = (f32x4){c.x, c.y, d.x, d.y}; }
                    v0 = v0 * sc; v1 = v1 * sc; u32x4 w; w.x = cvt_pk_bf16(v0[0], v0[1]); w.y = cvt_pk_bf16(v0[2], v0[3]); w.z = cvt_pk_bf16(v1[0], v1[1]); w.w = cvt_pk_bf16(v1[2], v1[3]);
                    *(u32x4*)(rowp + bj * HALF) = w; } }
    }
};

template <class Sink> struct Epi8 {
    static constexpr bool PERM = true, AFTER_DRAIN = false;
    Sink s;
    __device__ __forceinline__ void operator()(const f32x4 (&acc)[2][2][4][2], const Unit& u, int wr, int wc, int fr, int fq) const {
        const int row0 = u.pm * BM + wr * 64 + fr, col0 = u.pn * BM + wc * 32 + 8 * fq;
#pragma unroll
        for (int ai = 0; ai < 2; ++ai)
#pragma unroll
            for (int m = 0; m < 4; ++m)
#pragma unroll
                for (int bj = 0; bj < 2; ++bj) {
                    const f32x4 a0 = acc[ai][bj][m][0], a1 = acc[ai][bj][m][1];
                    const float v[8] = {a0[0], a0[1], a0[2], a0[3], a1[0], a1[1], a1[2], a1[3]};
                    s(row0 + ai * HALF + m * 16, col0 + bj * HALF, v);
                }
    }
};

template <class Epi, class Sched, bool ALIGN_EPI = false, bool SP2 = false>
__device__ __forceinline__ void gemm_phase(PG8_LAS unsigned char* lds, const Gemm g, const Sched& S, const Epi& E) {
    const int tid = threadIdx.x, wid = __builtin_amdgcn_readfirstlane(tid >> 6), lane = tid & 63, wr = wid >> 2, wc = wid & 3, fr = lane & 15, fq = lane >> 4;
    const int K = g.K, nt = K / BK;
    unsigned voffA[2], voffB[2];
#pragma unroll
    for (int i = 0; i < 2; ++i) { int R, C; stage_rc(tid * 16 + i * 8192, R, C); const int Rb = Epi::PERM ? ((R & ~31) + perm32(R & 31)) : R;
        voffA[i] = (unsigned)(R * K + C) * 2u; voffB[i] = (unsigned)(Rb * K + C) * 2u; }
    const size_t kstep = (size_t)(BK * 2);
    const size_t hstep = (size_t)HALF * K * 2;
    const size_t tstep = 2 * hstep;
    const unsigned ldsw = (unsigned)wid * 1024u;
    const int aoff = lds_byte(wr * 64 + fr, fq * 8), boff = lds_byte(wc * 32 + fr, fq * 8);
#define PG8_SA(b, h) (((b) * 2 + (h)) * HTB)
#define PG8_SB(b, h) ((4 + (b) * 2 + (h)) * HTB)
#define PG8_STAGE(bufoff, gbase, voff) do { _Pragma("unroll") for (int _i = 0; _i < 2; ++_i) \
        __builtin_amdgcn_global_load_lds((const unsigned*)((const char*)(gbase) + (voff)[_i]), (PG8_LAS unsigned*)(lds + (bufoff) + ldsw + _i * 8192), 16, 0, 0); } while (0)
#define PG8_LDA(dst, b, h) do { _Pragma("unroll") for (int m = 0; m < 4; ++m) _Pragma("unroll") for (int k = 0; k < 2; ++k) dst[m][k] = *(const PG8_LAS bf16x8*)(lds + PG8_SA(b, h) + aoff + m * 2048 + k * 1024); } while (0)
#define PG8_LDB(dst, b, h) do { _Pragma("unroll") for (int n = 0; n < 2; ++n) _Pragma("unroll") for (int k = 0; k < 2; ++k) dst[n][k] = *(const PG8_LAS bf16x8*)(lds + PG8_SB(b, h) + boff + n * 2048 + k * 1024); } while (0)
#define PG8_MMA(ai, bj, At, Bt) do { __builtin_amdgcn_s_setprio(1); _Pragma("unroll") for (int m = 0; m < 4; ++m) _Pragma("unroll") for (int n = 0; n < 2; ++n) _Pragma("unroll") for (int k = 0; k < 2; ++k) \
        acc[ai][bj][m][n] = __builtin_amdgcn_mfma_f32_16x16x32_bf16(Bt[n][k], At[m][k], acc[ai][bj][m][n], 0, 0, 0); __builtin_amdgcn_s_setprio(0); } while (0)
#define PG8_WAIT_V(n) asm volatile("s_waitcnt vmcnt(" #n ")" ::: "memory")
#define PG8_WAIT_L(n) asm volatile("s_waitcnt lgkmcnt(" #n ")" ::: "memory")
#define PG8_BAR __builtin_amdgcn_s_barrier()
#define PG8_SCHED __builtin_amdgcn_sched_barrier(0)
    Unit cur, nxt; int ui = 0;
    if (!S.next(0, cur)) return;
    f32x4 acc[2][2][4][2];
#pragma unroll
    for (int a = 0; a < 2; ++a)
#pragma unroll
        for (int b = 0; b < 2; ++b)
#pragma unroll
            for (int m = 0; m < 4; ++m)
#pragma unroll
                for (int n = 0; n < 2; ++n) acc[a][b][m][n] = (f32x4){0.f, 0.f, 0.f, 0.f};
    bf16x8 At[4][2], B0[2][2], B1[2][2];
    const char* cA = (const char*)g.A + (size_t)cur.pm * tstep; const char* cB = (const char*)g.Bt + (size_t)cur.pn * tstep;
    S.a_ready(cur);
    if constexpr (SP2) {
        PG8_STAGE(PG8_SB(0, 0), cB, voffB); PG8_STAGE(PG8_SB(0, 1), cB + hstep, voffB); PG8_STAGE(PG8_SA(0, 0), cA, voffA); PG8_STAGE(PG8_SA(0, 1), cA + hstep, voffA);
        if (wr == 1) PG8_BAR;
        PG8_WAIT_V(2); PG8_BAR;
        PG8_STAGE(PG8_SB(1, 0), cB + kstep, voffB); PG8_STAGE(PG8_SA(1, 0), cA + kstep, voffA); PG8_STAGE(PG8_SB(1, 1), cB + hstep + kstep, voffB);
        PG8_WAIT_V(6); PG8_BAR;
    } else {
        PG8_STAGE(PG8_SB(0, 0), cB, voffB); PG8_STAGE(PG8_SA(0, 0), cA, voffA); PG8_STAGE(PG8_SB(0, 1), cB + hstep, voffB); PG8_STAGE(PG8_SA(0, 1), cA + hstep, voffA);
        if (wr == 1) PG8_BAR;
        PG8_WAIT_V(4); PG8_BAR;
        PG8_STAGE(PG8_SB(1, 0), cB + kstep, voffB); PG8_STAGE(PG8_SA(1, 0), cA + kstep, voffA); PG8_STAGE(PG8_SB(1, 1), cB + hstep + kstep, voffB);
        PG8_WAIT_V(6); PG8_BAR;
    }
    for (;;) {
        const bool has_next = S.next(ui + 1, nxt);
        const char* nA = has_next ? (const char*)g.A + (size_t)nxt.pm * tstep : cA; const char* nB = has_next ? (const char*)g.Bt + (size_t)nxt.pn * tstep : cB;
        for (int t = 0; t < nt; t += 2) {
            const bool last = (t == nt - 2);
            const char* a1 = cA + (size_t)(t + 1) * kstep;
            const char* a2 = last ? nA : cA + (size_t)(t + 2) * kstep; const char* b2 = last ? nB : cB + (size_t)(t + 2) * kstep;
            const char* a3 = a2 + kstep; const char* b3 = b2 + kstep;
            if (last && has_next) S.a_ready(nxt);
            if constexpr (SP2) {
            PG8_LDB(B0, 0, 0); PG8_LDB(B1, 0, 1); PG8_SCHED; PG8_LDA(At, 0, 0); PG8_STAGE(PG8_SA(1, 1), a1 + hstep, voffA);
            PG8_WAIT_V(8); PG8_WAIT_L(0); PG8_BAR; PG8_MMA(0, 0, At, B0); PG8_MMA(0, 1, At, B1); PG8_BAR; PG8_SCHED;
            PG8_LDA(At, 0, 1); PG8_STAGE(PG8_SB(0, 0), b2, voffB); PG8_STAGE(PG8_SB(0, 1), b2 + hstep, voffB); PG8_STAGE(PG8_SA(0, 0), a2, voffA);
            PG8_WAIT_V(8); PG8_WAIT_L(0); PG8_BAR; PG8_MMA(1, 0, At, B0); PG8_MMA(1, 1, At, B1); PG8_BAR; PG8_SCHED;
            PG8_LDB(B0, 1, 0); PG8_LDB(B1, 1, 1); PG8_SCHED; PG8_LDA(At, 1, 0); PG8_STAGE(PG8_SA(0, 1), a2 + hstep, voffA);
            PG8_WAIT_V(8); PG8_WAIT_L(0); PG8_BAR; PG8_MMA(0, 0, At, B0); PG8_MMA(0, 1, At, B1); PG8_BAR; PG8_SCHED;
            PG8_LDA(At, 1, 1); PG8_STAGE(PG8_SB(1, 0), b3, voffB); PG8_STAGE(PG8_SB(1, 1), b3 + hstep, voffB); PG8_STAGE(PG8_SA(1, 0), a3, voffA);
            PG8_WAIT_V(8); PG8_WAIT_L(0); PG8_BAR; PG8_MMA(1, 0, At, B0); PG8_MMA(1, 1, At, B1); PG8_BAR; PG8_SCHED;
            } else {
            PG8_LDB(B0, 0, 0); PG8_SCHED; PG8_LDA(At, 0, 0); PG8_STAGE(PG8_SA(1, 1), a1 + hstep, voffA);
            PG8_WAIT_L(8); PG8_BAR; PG8_WAIT_L(0); PG8_MMA(0, 0, At, B0); PG8_BAR; PG8_SCHED;
            PG8_LDB(B1, 0, 1); PG8_STAGE(PG8_SB(0, 0), b2, voffB);
            PG8_BAR; PG8_WAIT_L(0); PG8_MMA(0, 1, At, B1); PG8_BAR;
            PG8_LDA(At, 0, 1); PG8_STAGE(PG8_SA(0, 0), a2, voffA);
            PG8_BAR; PG8_WAIT_L(0); PG8_MMA(1, 0, At, B0); PG8_BAR; PG8_SCHED;
            PG8_STAGE(PG8_SB(0, 1), b2 + hstep, voffB);
            PG8_WAIT_V(6); PG8_BAR; PG8_MMA(1, 1, At, B1); PG8_BAR;
            PG8_LDB(B0, 1, 0); PG8_SCHED; PG8_LDA(At, 1, 0); PG8_STAGE(PG8_SA(0, 1), a2 + hstep, voffA);
            PG8_WAIT_L(8); PG8_BAR; PG8_WAIT_L(0); PG8_MMA(0, 0, At, B0); PG8_BAR; PG8_SCHED;
            PG8_LDB(B1, 1, 1); PG8_STAGE(PG8_SB(1, 0), b3, voffB);
            PG8_BAR; PG8_WAIT_L(0); PG8_MMA(0, 1, At, B1); PG8_BAR;
            PG8_LDA(At, 1, 1); PG8_STAGE(PG8_SA(1, 0), a3, voffA);
            PG8_BAR; PG8_WAIT_L(0); PG8_MMA(1, 0, At, B0); PG8_BAR; PG8_SCHED;
            PG8_STAGE(PG8_SB(1, 1), b3 + hstep, voffB);
            PG8_WAIT_V(6); PG8_BAR; PG8_MMA(1, 1, At, B1); PG8_BAR;
            }
        }
        if constexpr (ALIGN_EPI) { if (wr == 0) PG8_BAR; }
        if constexpr (!Epi::AFTER_DRAIN) { E(acc, cur, wr, wc, fr, fq); S.done(cur); }
        if (!has_next) break;
#pragma unroll
        for (int a = 0; a < 2; ++a)
#pragma unroll
            for (int b = 0; b < 2; ++b)
#pragma unroll
                for (int m = 0; m < 4; ++m)
#pragma unroll
                    for (int n = 0; n < 2; ++n) acc[a][b][m][n] = (f32x4){0.f, 0.f, 0.f, 0.f};
        cur = nxt; cA = nA; cB = nB; ++ui;
        if constexpr (ALIGN_EPI) { if (wr == 1) PG8_BAR; }
    }
    PG8_WAIT_V(0);
    if constexpr (!ALIGN_EPI) { if (wr == 0) PG8_BAR; }
    PG8_BAR;
    if constexpr (Epi::AFTER_DRAIN) { E.fused(acc, cur, wr, wc, fr, fq, lds, wid, lane); S.done(cur); }
#undef PG8_SA
#undef PG8_SB
#undef PG8_STAGE
#undef PG8_LDA
#undef PG8_LDB
#undef PG8_MMA
#undef PG8_WAIT_V
#undef PG8_WAIT_L
#undef PG8_BAR
#undef PG8_SCHED
}
}

#ifndef PG8_SP2
#define PG8_SP2 true
#endif
#ifndef PG8_ALIGN
#define PG8_ALIGN true
#endif

#define GAS __attribute__((address_space(1)))
#define LAS __attribute__((address_space(3)))
typedef unsigned short bf16;
typedef unsigned v4u __attribute__((ext_vector_type(4)));
typedef float f32x4 __attribute__((ext_vector_type(4)));
typedef short bf16x8 __attribute__((ext_vector_type(8)));
typedef GAS unsigned gu32;
typedef GAS unsigned long long gu64;
#define RLX_AGENT __ATOMIC_RELAXED, __HIP_MEMORY_SCOPE_AGENT
#define LDS_WAIT() asm volatile("s_waitcnt lgkmcnt(0)" ::: "memory")
#define VM_WAIT() asm volatile("s_waitcnt vmcnt(0)" ::: "memory")
__device__ __forceinline__ unsigned long long rt() { return __builtin_amdgcn_s_memrealtime(); }
__device__ __forceinline__ unsigned f2bf(float f) { unsigned u = __builtin_bit_cast(unsigned, f); return (u + 0x7fffu + ((u >> 16) & 1u)) >> 16; }
__device__ __forceinline__ unsigned pk2(float lo, float hi) { return f2bf(lo) | (f2bf(hi) << 16); }

#define XB_TMO      128
#define XB_XCNT(j)  (256  + 64 * (j))
#define XB_XSUB(j)  (1280 + 64 * (j))
#define XB_XGEN(j)  (2304 + 64 * (j))
#define XB_TOP      3328
#define XB_TOPGEN   3392
#define XCD_BAR_WORDS 3456
#define XB_SPIN_CAP (1u << 18)

__device__ __forceinline__ unsigned xb_ld(unsigned* p)              { return __hip_atomic_load(p, __ATOMIC_RELAXED, __HIP_MEMORY_SCOPE_AGENT); }
__device__ __forceinline__ unsigned xb_add(unsigned* p, unsigned v) { return __hip_atomic_fetch_add(p, v, __ATOMIC_RELAXED, __HIP_MEMORY_SCOPE_AGENT); }
__device__ __forceinline__ unsigned xb_xcc_id() { return (unsigned)__builtin_amdgcn_s_getreg((3 << 11) | 20) & 0xFu; }
#define XB_SPIN(cond, bar) do { unsigned _sp = 0; while (cond) { __builtin_amdgcn_s_sleep(1); \
    if ((++_sp & 255u) == 0u) { if (xb_ld(&(bar)[XB_TMO])) break; if (_sp > XB_SPIN_CAP) { atomicAdd(&(bar)[XB_TMO], 1u); break; } } } } while (0)

struct XcdBarrier {
    unsigned* bar; unsigned x;
    volatile LAS unsigned* st;
};

__device__ __forceinline__ XcdBarrier xcd_barrier_post(unsigned* bar, volatile LAS unsigned* st) {
    XcdBarrier b; b.bar = bar; b.x = xb_xcc_id(); b.st = st;
    if (threadIdx.x == 0) (void)xb_add(&bar[XB_XCNT(b.x)], 1u);
    return b;
}
__device__ __forceinline__ void xcd_barrier_complete(unsigned* bar, unsigned x, unsigned& nloc, unsigned& nx) {
    const unsigned G = gridDim.x * gridDim.y * gridDim.z;
    unsigned sum, cnt, mine, sp = 0u;
    for (;;) {
        sum = 0u; cnt = 0u; mine = 0u;
#pragma unroll
        for (unsigned j = 0; j < 16; ++j) { const unsigned c = xb_ld(&bar[XB_XCNT(j)]); sum += c; cnt += (c > 0u) ? 1u : 0u; mine = (j == x) ? c : mine; }
        if (sum == G) break;
        __builtin_amdgcn_s_sleep(1);
        if ((++sp & 255u) == 0u) { if (xb_ld(&bar[XB_TMO])) break; if (sp > XB_SPIN_CAP) { atomicAdd(&bar[XB_TMO], 1u); break; } }
    }
    nloc = mine > 0u ? mine : 1u; nx = cnt > 0u ? cnt : 1u;
}

__device__ __forceinline__ void xcd_barrier(const XcdBarrier& b) {
    asm volatile("s_waitcnt vmcnt(0)" ::: "memory");
    __syncthreads();
    if (threadIdx.x == 0) {
        unsigned* bar = b.bar;
        __builtin_amdgcn_s_waitcnt(0);
        unsigned nloc = b.st[0], nx = b.st[1];
        if (nloc == 0u) { xcd_barrier_complete(bar, b.x, nloc, nx); b.st[0] = nloc; b.st[1] = nx; }
        const unsigned old = xb_add(&bar[XB_XSUB(b.x)], 1u);
        const unsigned gen = old / nloc;
        if (old + 1u == (gen + 1u) * nloc) {
            __builtin_amdgcn_fence(__ATOMIC_RELEASE, "agent");
            asm volatile("s_waitcnt vmcnt(0)" ::: "memory");
            const unsigned og = xb_add(&bar[XB_TOP], 1u);
            const unsigned tg = og / nx;
            if (og + 1u == (tg + 1u) * nx) xb_add(&bar[XB_TOPGEN], 1u);
            else XB_SPIN(xb_ld(&bar[XB_TOPGEN]) == tg, bar);
            __builtin_amdgcn_fence(__ATOMIC_ACQUIRE, "agent");
            xb_add(&bar[XB_XGEN(b.x)], 1u);
            asm volatile("s_waitcnt vmcnt(0)" ::: "memory");
        } else {
            XB_SPIN(xb_ld(&bar[XB_XGEN(b.x)]) == gen, bar);
            __builtin_amdgcn_fence(__ATOMIC_ACQUIRE, "agent");
            asm volatile("s_waitcnt vmcnt(0)" ::: "memory");
        }
    }
    __syncthreads();
}

constexpr int NWAVES = 8, NTHR = 512;
constexpr int DM = 2048, NTOK = 8192, SEQ = 4096;
constexpr int DS5 = 1024, NGRP = 64, GH = 16, NST = 64;
constexpr int NHEAD = 4, GDK = 512, GDV = 1024, HK = 128, HV = 256, RANK = 16, CHUNK = 64, NCHUNK = 64;
constexpr int DIN = 5136, DINP = 5376;
constexpr float EPS = 1e-6f;
enum { I_X = 0, I_PREW, I_WIN, I_ARE, I_AIM, I_BRE, I_BIM, I_CRE, I_CIM, I_D, I_LOGDT, I_GLUW, I_GLUB, I_GUP, I_GBIAS, I_GNORM, I_WOUT, I_POSTW, N_IN };

constexpr size_t MiB = 1u << 20;
constexpr size_t WS_CTL = 0, CTL_ZERO_BYTES = 65536;
constexpr size_t WS_WIN = 1 * MiB;
constexpr size_t WS_WGLU = 22 * MiB;
constexpr size_t WS_WOUT = 24 * MiB;
constexpr size_t WS_XN = 32 * MiB;
constexpr size_t WS_KVT = 32 * MiB;
constexpr size_t WS_CONCAT = 32 * MiB;
constexpr size_t WS_UT = 64 * MiB;
constexpr size_t WS_ZS5 = 80 * MiB;
constexpr size_t WS_MIXED = 64 * MiB;
constexpr size_t WS_Q = 96 * MiB;
constexpr size_t WS_K = 104 * MiB;
constexpr size_t WS_V = 112 * MiB;
constexpr size_t WS_ZGLA = 128 * MiB;
constexpr size_t WS_GLOW = 144 * MiB;
constexpr size_t WS_DEC = 145 * MiB;
constexpr size_t WS_SLOC = 146 * MiB;
constexpr size_t WS_KT = 150 * MiB;
constexpr size_t WS_AT = 153 * MiB;
constexpr size_t WS_W1 = 154 * MiB;
constexpr size_t WS_W2 = 170 * MiB;
constexpr size_t WS_YPRE = 186 * MiB;
constexpr size_t WS_SPT = 202 * MiB;
constexpr size_t WS_END = 234 * MiB;
constexpr int CW_BAR = 4096;

constexpr int RING_OFF = 0, RING_BYTES = 131072;
constexpr int LDSCTL_OFF = RING_BYTES, MISC_OFF = LDSCTL_OFF + 320;
constexpr int LDS_BYTES = 147456;

struct Args { const float* in[N_IN]; float* out; unsigned char* ws; int ph_lo, ph_hi; };
static_assert(sizeof(Args) == N_IN * 8 + 8 + 8 + 8, "Args has no padding");

struct Frame {
    LAS unsigned char* lds; volatile LAS unsigned* MISC; gu32* ctl;
    int tid, lane, wave, vcu, G;
};

__device__ __forceinline__ float wave_sum(float v) {
#pragma unroll
    for (int o = 1; o < 64; o <<= 1) v += __shfl_xor(v, o);
    return v;
}
__device__ __forceinline__ float bf2f(unsigned short b) { return __builtin_bit_cast(float, ((unsigned)b) << 16); }
__device__ __forceinline__ void store8bf(bf16* p, const float (&v)[8]) {
    v4u w; w.x = pg8::cvt_pk_bf16(v[0], v[1]); w.y = pg8::cvt_pk_bf16(v[2], v[3]); w.z = pg8::cvt_pk_bf16(v[4], v[5]); w.w = pg8::cvt_pk_bf16(v[6], v[7]);
    *(v4u*)p = w;
}
__device__ __forceinline__ void load8bf(const bf16* p, float (&v)[8]) {
    const v4u w = *(const v4u*)p;
    v[0] = __builtin_bit_cast(float, w.x << 16); v[1] = __builtin_bit_cast(float, w.x & 0xffff0000u);
    v[2] = __builtin_bit_cast(float, w.y << 16); v[3] = __builtin_bit_cast(float, w.y & 0xffff0000u);
    v[4] = __builtin_bit_cast(float, w.z << 16); v[5] = __builtin_bit_cast(float, w.z & 0xffff0000u);
    v[6] = __builtin_bit_cast(float, w.w << 16); v[7] = __builtin_bit_cast(float, w.w & 0xffff0000u);
}
__device__ __forceinline__ float sigmoidf_(float x) { return 1.0f / (1.0f + __expf(-x)); }
__device__ __forceinline__ float siluf_(float x) { return x * sigmoidf_(x); }
__device__ __forceinline__ float gelu_tanh(float x) {
    const float z = 0.7978845608028654f * (x + 0.044715f * x * x * x);
    const float t = 1.0f - 2.0f / (1.0f + __expf(2.0f * z));
    return 0.5f * x * (1.0f + t);
}
__device__ __forceinline__ float log_sigmoid(float z) { return fminf(z, 0.f) - log1pf(__expf(-fabsf(z))); }
__device__ __forceinline__ void cexp_dt(float ar, float ai, float dt, float mult, float& re, float& im) {
    const double th = (double)ai * (double)dt * (double)mult;
    const double k = __builtin_rint(th * 0.15915494309189535);
    const float r = (float)(th - k * 6.283185307179586);
    const float mag = expf(ar * dt * mult);
    re = mag * cosf(r); im = mag * sinf(r);
}

struct ProjSink {
    bf16 *UT, *ZS5, *Q, *K, *V, *ZGLA; float* GLOW;
    __device__ __forceinline__ void operator()(int row, int c0, const float (&v)[8]) const {
        if (c0 < 1024) { const int g = c0 >> 4; store8bf(UT + ((size_t)g * NTOK + row) * 16 + (c0 & 15), v); }
        else if (c0 < 2048) { float o[8];
#pragma unroll
            for (int i = 0; i < 8; ++i) o[i] = siluf_(v[i]);
            store8bf(ZS5 + (size_t)row * 1024 + (c0 - 1024), o); }
        else if (c0 < 2560) { float o[8];
#pragma unroll
            for (int i = 0; i < 8; ++i) o[i] = v[i] * 0.08838834764831845f;
            store8bf(Q + (size_t)row * 512 + (c0 - 2048), o); }
        else if (c0 < 3072) store8bf(K + (size_t)row * 512 + (c0 - 2560), v);
        else if (c0 < 4096) store8bf(V + (size_t)row * 1024 + (c0 - 3072), v);
        else if (c0 < 5120) { float o[8];
#pragma unroll
            for (int i = 0; i < 8; ++i) o[i] = siluf_(v[i]);
            store8bf(ZGLA + (size_t)row * 1024 + (c0 - 4096), o); }
        else if (c0 < DIN) { float* p = GLOW + (size_t)row * 16 + (c0 - 5120);
            *(f32x4*)p = (f32x4){v[0], v[1], v[2], v[3]}; *(f32x4*)(p + 4) = (f32x4){v[4], v[5], v[6], v[7]}; }
    }
};
struct GluSink {
    const bf16 *YPRE, *ZS5; const float* glub; bf16* CONCAT;
    __device__ __forceinline__ void operator()(int row, int c0, const float (&v)[8]) const {
        float y[8], g[8], o[8]; load8bf(YPRE + (size_t)row * 1024 + c0, y); load8bf(ZS5 + (size_t)row * 1024 + c0, g);
        const f32x4 b0 = *(const f32x4*)(glub + c0), b1 = *(const f32x4*)(glub + c0 + 4);
        const float b[8] = {b0[0], b0[1], b0[2], b0[3], b1[0], b1[1], b1[2], b1[3]};
#pragma unroll
        for (int i = 0; i < 8; ++i) o[i] = y[i] * sigmoidf_(v[i] + b[i]) * g[i];
        store8bf(CONCAT + (size_t)row * 2048 + c0, o);
    }
};
struct MixSink {
    bf16* MIXED;
    __device__ __forceinline__ void operator()(int row, int c0, const float (&v)[8]) const { store8bf(MIXED + (size_t)row * 2048 + c0, v); }
};

template <class Sink> __device__ __forceinline__ void naive_gemm(const bf16* A, const bf16* Bt, int M, int N, int K, const Sink& s, int gtid, int gthreads) {
    const int n8 = N / 8; const long total = (long)M * n8;
    for (long it = gtid; it < total; it += gthreads) {
        const int c0 = (int)(it % n8) * 8, row = (int)(it / n8);
        float acc[8] = {0.f, 0.f, 0.f, 0.f, 0.f, 0.f, 0.f, 0.f};
        for (int k = 0; k < K; k += 8) {
            float a[8]; load8bf(A + (size_t)row * K + k, a);
#pragma unroll
            for (int i = 0; i < 8; ++i) { float b[8]; load8bf(Bt + (size_t)(c0 + i) * K + k, b);
#pragma unroll
                for (int j = 0; j < 8; ++j) acc[i] += a[j] * b[j]; }
        }
        s(row, c0, acc);
    }
}

__device__ __forceinline__ void p0_transpose_item(const float* W, int K, int N, int Npad, bf16* WT, LAS float* scr, int item, int lane) {
    const int nblk = Npad / 32, kb = item / nblk, nb = item % nblk, k0 = 64 * kb, n0 = 32 * nb;
    const int nl = n0 + (lane & 31); const bool ok = nl < N;
#pragma unroll 8
    for (int i = 0; i < 32; ++i) { const int kk = 2 * i + (lane >> 5); scr[kk * 33 + (lane & 31)] = ok ? W[(size_t)(k0 + kk) * N + nl] : 0.f; }
    LDS_WAIT(); asm volatile("" ::: "memory");
    const int c = lane & 7;
#pragma unroll
    for (int j = 0; j < 4; ++j) { const int n = (lane >> 3) + 8 * j; const LAS float* s = scr + (8 * c) * 33 + n;
        v4u o; o.x = pg8::cvt_pk_bf16(s[0 * 33], s[1 * 33]); o.y = pg8::cvt_pk_bf16(s[2 * 33], s[3 * 33]); o.z = pg8::cvt_pk_bf16(s[4 * 33], s[5 * 33]); o.w = pg8::cvt_pk_bf16(s[6 * 33], s[7 * 33]);
        *(v4u*)(WT + (size_t)(n0 + n) * K + k0 + 8 * c) = o; }
    LDS_WAIT(); asm volatile("" ::: "memory");
}
__device__ __forceinline__ void p0_xn_row(const float* xrow, const float* w, bf16* orow, int lane) {
    const f32x4* xr = (const f32x4*)xrow + lane; const f32x4* wr = (const f32x4*)w + lane;
    f32x4 v[8]; float s = 0.f;
#pragma unroll
    for (int j = 0; j < 8; ++j) { v[j] = xr[64 * j]; s += (v[j].x * v[j].x + v[j].y * v[j].y) + (v[j].z * v[j].z + v[j].w * v[j].w); }
    const float rstd = 1.0f / sqrtf(wave_sum(s) * (1.0f / DM) + EPS);
    unsigned long long* o8 = (unsigned long long*)orow + lane;
#pragma unroll
    for (int j = 0; j < 8; ++j) { const f32x4 wv = wr[64 * j]; const f32x4 o = v[j] * rstd * wv;
        o8[64 * j] = (unsigned long long)pg8::cvt_pk_bf16(o.x, o.y) | ((unsigned long long)pg8::cvt_pk_bf16(o.z, o.w) << 32); }
}
__device__ __forceinline__ void p0_prologue(const Frame& F, const Args& a) {
    LAS float* scr = (LAS float*)(F.lds + RING_OFF + F.wave * 16384);
    const int gw = F.vcu * NWAVES + F.wave, NGW = F.G * NWAVES;
    constexpr int I_IN = (DM / 64) * (DINP / 32), I_GLU = (DS5 / 64) * (DS5 / 32), I_OUT = (DM / 64) * (DM / 32);
    constexpr int NITEMS = I_IN + I_GLU + I_OUT;
    for (int it = gw; it < NITEMS; it += NGW) {
        int r = it;
        if (r < I_IN) { p0_transpose_item(a.in[I_WIN], DM, DIN, DINP, (bf16*)(a.ws + WS_WIN), scr, r, F.lane); continue; } r -= I_IN;
        if (r < I_GLU) { p0_transpose_item(a.in[I_GLUW], DS5, DS5, DS5, (bf16*)(a.ws + WS_WGLU), scr, r, F.lane); continue; } r -= I_GLU;
        p0_transpose_item(a.in[I_WOUT], DM, DM, DM, (bf16*)(a.ws + WS_WOUT), scr, r, F.lane);
    }
    for (int m = gw; m < NTOK; m += NGW) p0_xn_row(a.in[I_X] + (size_t)m * DM, a.in[I_PREW], (bf16*)(a.ws + WS_XN) + (size_t)m * DM, F.lane);
}

__device__ __forceinline__ void s5_naive_item(const Args& a, int item, int lane) {
    const int b = item / NGRP, g = item % NGRP, p = lane;
    const float ar = fminf(a.in[I_ARE][g * NST + p], -1e-4f), ai = a.in[I_AIM][g * NST + p];
    const float dt = expf(a.in[I_LOGDT][g]);
    float abr, abi; cexp_dt(ar, ai, dt, 1.0f, abr, abi);
    const float xr = abr - 1.0f, xi = abi, den = 1.0f / (ar * ar + ai * ai);
    const float cr = (xr * ar + xi * ai) * den, ci = (xi * ar - xr * ai) * den;
    float Bbr[GH], Bbi[GH], Ccr[GH], Cci[GH], Dv[GH];
#pragma unroll
    for (int h = 0; h < GH; ++h) {
        const float br = a.in[I_BRE][(g * NST + p) * GH + h], bi = a.in[I_BIM][(g * NST + p) * GH + h];
        Bbr[h] = cr * br - ci * bi; Bbi[h] = cr * bi + ci * br;
        Ccr[h] = a.in[I_CRE][(g * GH + h) * NST + p]; Cci[h] = a.in[I_CIM][(g * GH + h) * NST + p];
        Dv[h] = a.in[I_D][g * GH + h];
    }
    const bf16* U = (const bf16*)(a.ws + WS_UT) + ((size_t)g * NTOK + (size_t)b * SEQ) * 16;
    bf16* Y = (bf16*)(a.ws + WS_YPRE) + (size_t)b * SEQ * DS5 + g * GH;
    float sr = 0.f, si = 0.f;
    for (int t = 0; t < SEQ; ++t) {
        float u[16]; { float u0[8], u1[8]; load8bf(U + (size_t)t * 16, u0); load8bf(U + (size_t)t * 16 + 8, u1);
#pragma unroll
            for (int i = 0; i < 8; ++i) { u[i] = u0[i]; u[8 + i] = u1[i]; } }
        float bur = 0.f, bui = 0.f;
#pragma unroll
        for (int h = 0; h < GH; ++h) { bur += Bbr[h] * u[h]; bui += Bbi[h] * u[h]; }
        const float nr = abr * sr - abi * si + bur, ni = abr * si + abi * sr + bui; sr = nr; si = ni;
        float mine = 0.f;
#pragma unroll
        for (int h = 0; h < GH; ++h) { const float y = wave_sum(Ccr[h] * sr - Cci[h] * si) + Dv[h] * u[h]; mine = (lane == h) ? y : mine; }
        if (lane < GH) { const float o = gelu_tanh(mine); Y[(size_t)t * DS5 + lane] = (bf16)(pg8::cvt_pk_bf16(o, 0.f) & 0xffffu); }
    }
}

__device__ __forceinline__ void gla_naive_item(const Frame& F, const Args& a, int item) {
    const int b = item / NHEAD, h = item % NHEAD, tid = F.tid, dv = tid & 255, half = tid >> 8;
    LAS float* qs = (LAS float*)(F.lds + RING_OFF); LAS float* ks = qs + 128; LAS float* gs = ks + 128; LAS float* part = gs + 128; LAS float* red = part + 512;
    float S[64];
#pragma unroll
    for (int j = 0; j < 64; ++j) S[j] = 0.f;
    float gu[RANK]; float gb = 0.f;
    if (tid < HK) {
#pragma unroll
        for (int r = 0; r < RANK; ++r) gu[r] = a.in[I_GUP][r * GDK + h * HK + tid];
        gb = a.in[I_GBIAS][h * HK + tid];
    } else {
#pragma unroll
        for (int r = 0; r < RANK; ++r) gu[r] = 0.f;
    }
    const float nw = a.in[I_GNORM][dv];
    const bf16* Q = (const bf16*)(a.ws + WS_Q); const bf16* K = (const bf16*)(a.ws + WS_K); const bf16* V = (const bf16*)(a.ws + WS_V);
    const bf16* ZG = (const bf16*)(a.ws + WS_ZGLA); const float* GL = (const float*)(a.ws + WS_GLOW); bf16* CC = (bf16*)(a.ws + WS_CONCAT);
    for (int t = 0; t < SEQ; ++t) {
        const size_t tok = (size_t)b * SEQ + t;
        if (tid < HK) {
            float z = gb;
#pragma unroll
            for (int r = 0; r < RANK; ++r) z += GL[tok * 16 + r] * gu[r];
            gs[tid] = __expf(log_sigmoid(z) * (1.0f / 16.0f));
            qs[tid] = bf2f(Q[tok * GDK + h * HK + tid]); ks[tid] = bf2f(K[tok * GDK + h * HK + tid]);
        }
        __syncthreads();
        const float v = bf2f(V[tok * GDV + h * HV + dv]);
        float o = 0.f;
#pragma unroll
        for (int j = 0; j < 64; ++j) { const int dk = half * 64 + j; S[j] = gs[dk] * S[j] + ks[dk] * v; o += qs[dk] * S[j]; }
        part[tid] = o;
        __syncthreads();
        float ot = 0.f;
        if (half == 0) { ot = part[dv] + part[256 + dv]; const float ss = wave_sum(ot * ot); if (F.lane == 0) red[F.wave] = ss; }
        __syncthreads();
        if (half == 0) { const float tot = (red[0] + red[1]) + (red[2] + red[3]); const float rstd = 1.0f / sqrtf(tot * (1.0f / HV) + EPS);
            const float res = ot * rstd * nw * bf2f(ZG[tok * GDV + h * HV + dv]);
            CC[tok * 2048 + 1024 + h * HV + dv] = (bf16)(pg8::cvt_pk_bf16(res, 0.f) & 0xffffu); }
        __syncthreads();
    }
}

__device__ __forceinline__ void p6_row(const float* xrow, const bf16* mrow, const float* pw, float* orow, int lane) {
    float m[4][8]; float s = 0.f;
#pragma unroll
    for (int j = 0; j < 4; ++j) { load8bf(mrow + (size_t)(lane + 64 * j) * 8, m[j]);
#pragma unroll
        for (int i = 0; i < 8; ++i) s += m[j][i] * m[j][i]; }
    const float rstd = 1.0f / sqrtf(wave_sum(s) * (1.0f / DM) + EPS);
#pragma unroll
    for (int j = 0; j < 4; ++j) { const int c = (lane + 64 * j) * 8;
#pragma unroll
        for (int q = 0; q < 2; ++q) { const f32x4 xv = *(const f32x4*)(xrow + c + 4 * q), wv = *(const f32x4*)(pw + c + 4 * q);
            const f32x4 mv = (f32x4){m[j][4 * q], m[j][4 * q + 1], m[j][4 * q + 2], m[j][4 * q + 3]};
            *(f32x4*)(orow + c + 4 * q) = xv + mv * rstd * wv; } }
}

constexpr int NPHASE = 7;
__global__ void __launch_bounds__(NTHR, 2) mega_fwd(Args a) {
    extern __shared__ __attribute__((aligned(16))) unsigned char lds[];
    Frame F;
    F.lds = (LAS unsigned char*)lds; F.MISC = (volatile LAS unsigned*)(F.lds + MISC_OFF);
    F.tid = threadIdx.x; F.lane = F.tid & 63; F.wave = __builtin_amdgcn_readfirstlane(F.tid >> 6);
    F.G = gridDim.x; { const int bx = blockIdx.x; F.vcu = (F.G % 8 == 0) ? (bx % 8) * (F.G / 8) + bx / 8 : bx; }
    F.ctl = (gu32*)(a.ws + WS_CTL);
    for (int u = F.tid; u < (LDS_BYTES - LDSCTL_OFF) / 4; u += NTHR) ((LAS unsigned*)(F.lds + LDSCTL_OFF))[u] = 0u;
    __syncthreads();
    const int lo = a.ph_lo, hi = a.ph_hi;
    const bool use_bar = (hi - lo) > 1;
    XcdBarrier bar; bar.bar = (unsigned*)(F.ctl + CW_BAR); bar.x = 0; bar.st = nullptr;
    if (use_bar) bar = xcd_barrier_post((unsigned*)(F.ctl + CW_BAR), F.MISC + 8);
#define IN(k) (lo <= (k) && (k) < hi)
#define SEAM(k) do { if (IN(k) && IN((k) + 1)) xcd_barrier(bar); } while (0)
    const int gtid = blockIdx.x * NTHR + F.tid, gthreads = F.G * NTHR;
    const int gw = blockIdx.x * NWAVES + F.wave, NGW = F.G * NWAVES;
    unsigned char* ws = a.ws;

    if (IN(0)) { p0_prologue(F, a); }
    SEAM(0);

    if (IN(1)) {
        ProjSink ps{(bf16*)(ws + WS_UT), (bf16*)(ws + WS_ZS5), (bf16*)(ws + WS_Q), (bf16*)(ws + WS_K), (bf16*)(ws + WS_V), (bf16*)(ws + WS_ZGLA), (float*)(ws + WS_GLOW)};
#if FAST_GEMM
        pg8::Gemm g{(const pg8::bf16_t*)(ws + WS_XN), (const pg8::bf16_t*)(ws + WS_WIN), NTOK, DINP, DM}; pg8::StaticOrder S; S.init(NTOK, DINP, F.G, (int)blockIdx.x);
        pg8::Epi8<ProjSink> E{ps};
        pg8::gemm_phase<pg8::Epi8<ProjSink>, pg8::StaticOrder, PG8_ALIGN, PG8_SP2>(F.lds + RING_OFF, g, S, E);
#else
        naive_gemm((const bf16*)(ws + WS_XN), (const bf16*)(ws + WS_WIN), NTOK, DINP, DM, ps, gtid, gthreads);
#endif
    }
    SEAM(1);

    if (IN(2)) { }
    SEAM(2);

    if (IN(3)) {
#if !FAST_GLA
        if (blockIdx.x < 8) gla_naive_item(F, a, (int)blockIdx.x);
#endif
#if !FAST_S5
        if (blockIdx.x >= 8 && blockIdx.x < 8 + 16) s5_naive_item(a, ((int)blockIdx.x - 8) * NWAVES + F.wave, F.lane);
#endif
    }
    SEAM(3);

    if (IN(4)) {
        GluSink gs{(const bf16*)(ws + WS_YPRE), (const bf16*)(ws + WS_ZS5), a.in[I_GLUB], (bf16*)(ws + WS_CONCAT)};
#if FAST_GEMM
        pg8::Gemm g{(const pg8::bf16_t*)(ws + WS_YPRE), (const pg8::bf16_t*)(ws + WS_WGLU), NTOK, DS5, DS5}; pg8::StaticOrder S; S.init(NTOK, DS5, F.G, (int)blockIdx.x);
        pg8::Epi8<GluSink> E{gs};
        pg8::gemm_phase<pg8::Epi8<GluSink>, pg8::StaticOrder, PG8_ALIGN, PG8_SP2>(F.lds + RING_OFF, g, S, E);
#else
        naive_gemm((const bf16*)(ws + WS_YPRE), (const bf16*)(ws + WS_WGLU), NTOK, DS5, DS5, gs, gtid, gthreads);
#endif
    }
    SEAM(4);

    if (IN(5)) {
        MixSink ms{(bf16*)(ws + WS_MIXED)};
#if FAST_GEMM
        pg8::Gemm g{(const pg8::bf16_t*)(ws + WS_CONCAT), (const pg8::bf16_t*)(ws + WS_WOUT), NTOK, DM, DM}; pg8::StaticOrder S; S.init(NTOK, DM, F.G, (int)blockIdx.x);
        pg8::Epi8<MixSink> E{ms};
        pg8::gemm_phase<pg8::Epi8<MixSink>, pg8::StaticOrder, PG8_ALIGN, PG8_SP2>(F.lds + RING_OFF, g, S, E);
#else
        naive_gemm((const bf16*)(ws + WS_CONCAT), (const bf16*)(ws + WS_WOUT), NTOK, DM, DM, ms, gtid, gthreads);
#endif
    }
    SEAM(5);

    if (IN(6)) {
        for (int m = gw; m < NTOK; m += NGW) p6_row(a.in[I_X] + (size_t)m * DM, (const bf16*)(ws + WS_MIXED) + (size_t)m * DM, a.in[I_POSTW], a.out + (size_t)m * DM, F.lane);
    }
#undef IN
#undef SEAM
}

extern "C" void kernel_launch(void* const* d_in, const int* in_sizes, int n_in, void* d_out, int out_size, void* d_ws, size_t ws_size, hipStream_t stream) {
    static int grid = 0;
    if (grid == 0) {
        if (n_in != N_IN || out_size != NTOK * DM || ws_size < WS_END) { fprintf(stderr, "kernel_launch: unexpected problem shape (n_in %d out %d ws %zu)\n", n_in, out_size, ws_size); grid = -1; return; }
        int dev = 0, cus = 0;
        if (hipGetDevice(&dev) != hipSuccess || hipDeviceGetAttribute(&cus, hipDeviceAttributeMultiprocessorCount, dev) != hipSuccess) { grid = -1; return; }
        if (hipFuncSetAttribute((const void*)mega_fwd, hipFuncAttributeMaxDynamicSharedMemorySize, LDS_BYTES) != hipSuccess) { fprintf(stderr, "kernel_launch: hipFuncSetAttribute failed\n"); grid = -1; return; }
        grid = cus;
    }
    if (grid < 0) return;
    (void)hipMemsetAsync((char*)d_ws + WS_CTL, 0, CTL_ZERO_BYTES, stream);
    Args a{};
    for (int i = 0; i < N_IN; ++i) a.in[i] = (const float*)d_in[i];
    a.out = (float*)d_out; a.ws = (unsigned char*)d_ws;
#if MK_ONE_LAUNCH
    a.ph_lo = 0; a.ph_hi = NPHASE;
    hipLaunchKernelGGL(mega_fwd, dim3(grid), dim3(NTHR), LDS_BYTES, stream, a);
#else
    for (int p = 0; p < NPHASE; ++p) {
        if (p == 2 && !(FAST_S5 || FAST_GLA)) continue;
        a.ph_lo = p; a.ph_hi = p + 1;
        hipLaunchKernelGGL(mega_fwd, dim3(grid), dim3(NTHR), LDS_BYTES, stream, a);
    }
#endif
}
```

```cpp
#include <hip/hip_runtime.h>
#include <cstdio>
#include <cstdint>

#define MK_ONE_LAUNCH 1
#define FAST_GEMM 1
#define FAST_S5 1
#define FAST_GLA 1

namespace pg8 {
#define PG8_LAS __attribute__((address_space(3)))
typedef unsigned short bf16_t;
typedef short bf16x8 __attribute__((ext_vector_type(8)));
typedef float f32x4 __attribute__((ext_vector_type(4)));
typedef unsigned u32x4 __attribute__((ext_vector_type(4)));
constexpr int BM = 256, BK = 64, HALF = 128, HTB = HALF * BK * 2  , STAGE_BYTES = 8 * HTB, NXCD = 8, WGM = 8;

__host__ __device__ __forceinline__ int lds_byte(int r, int c) { const int st = (r >> 4) * 2 + (c >> 5), rr = r & 15, cc = c & 31, ob = rr * 64 + cc * 2; return st * 1024 + (ob ^ (((ob >> 9) & 1) << 5)); }
__host__ __device__ __forceinline__ void stage_rc(int b, int& R, int& C) { const int st = b / 1024, sb = b % 1024, swz = sb ^ (((sb >> 9) & 1) << 5); R = (st >> 1) * 16 + swz / 64; C = (st & 1) * 32 + (swz % 64) / 2; }
__host__ __device__ __forceinline__ int perm32(int rho) { const int n = rho >> 4, i = rho & 15; return 8 * (i >> 2) + 4 * n + (i & 3); }

struct Unit { int pm, pn; };
struct Gemm { const bf16_t* A; const bf16_t* Bt; int M, N, K; };

struct StaticOrder {
    int nM, nN, nwg, G, c;
    __host__ __device__ void init(int M, int N, int G_, int c_) { nM = M / BM; nN = N / BM; nwg = nM * nN; G = G_; c = c_; }
    __host__ __device__ bool next(int i, Unit& u) const {
        const long L = (long)i * G + c; if (L >= nwg) return false;
        int wgid = (int)L; { const int q = nwg / NXCD, r = nwg % NXCD, xcd = wgid % NXCD, off = wgid / NXCD; wgid = (xcd < r ? xcd * (q + 1) : r * (q + 1) + (xcd - r) * q) + off; }
        const int nig = WGM * nN, gid = wgid / nig, fm = gid * WGM, gsz = (nM - fm) < WGM ? (nM - fm) : WGM;
        u.pm = fm + ((wgid % nig) % gsz); u.pn = (wgid % nig) / gsz; return true;
    }
    __device__ __forceinline__ void a_ready(const Unit&) const {}
    __device__ __forceinline__ void done(const Unit&) const {}
};

__device__ __forceinline__ unsigned cvt_pk_bf16(float lo, float hi) { unsigned r; asm volatile("v_cvt_pk_bf16_f32 %0, %1, %2" : "=v"(r) : "v"(lo), "v"(hi)); return r; }
typedef float f32x2 __attribute__((ext_vector_type(2)));
__device__ __forceinline__ f32x2 gelu_pk(f32x2 v) {
    const f32x2 av = __builtin_elementwise_abs(v), d = av * 0.2316418882f + 1.0f;
    f32x2 t; t.x = __builtin_amdgcn_rcpf(d.x); t.y = __builtin_amdgcn_rcpf(d.y);
    f32x2 q = t * 0.5307027145f + (-0.7265760135f); q = q * t + 0.7107068705f; q = q * t + (-0.142248368f); q = q * t + 0.127414796f; q = q * t;
    const f32x2 s = (v * v) * (-0.72134752044f);
    f32x2 e; e.x = __builtin_amdgcn_exp2f(s.x); e.y = __builtin_amdgcn_exp2f(s.y);
    const f32x2 m = v * (q * e), r = v - m;
    f32x2 o; o.x = v.x < 0.f ? m.x : r.x; o.y = v.y < 0.f ? m.y : r.y; return o;
}

template <int ACT  > struct EpiBf16 {
    static constexpr bool PERM = true, AFTER_DRAIN = false; static_assert(ACT == 0 || ACT == 1, "EpiBf16: ACT is 0 (none) or 1 (gelu_pk)");
    bf16_t* O; int ldc; const float* bias; int split_cols; size_t split_stride; float scale0;
    __device__ __forceinline__ void operator()(const f32x4 (&acc)[2][2][4][2], const Unit& u, int wr, int wc, int fr, int fq) const {
        const int row0 = u.pm * BM + wr * 64 + fr; int colt = u.pn * BM; bf16_t* base = O;
        float sc = 1.f; if (split_cols) { const int t = colt / split_cols; base += (size_t)t * split_stride; colt -= t * split_cols; if (t == 0) sc = scale0; }
        const int col0 = colt + wc * 32 + 8 * fq, bcol0 = u.pn * BM + wc * 32 + 8 * fq;
        f32x4 bv[2][2];
#pragma unroll
        for (int bj = 0; bj < 2; ++bj)
#pragma unroll
            for (int n = 0; n < 2; ++n) bv[bj][n] = bias ? *(const f32x4*)(bias + bcol0 + bj * HALF + 4 * n) : (f32x4){0.f, 0.f, 0.f, 0.f};
#pragma unroll
        for (int ai = 0; ai < 2; ++ai)
#pragma unroll
            for (int m = 0; m < 4; ++m) { bf16_t* rowp = base + (size_t)(row0 + ai * HALF + m * 16) * ldc + col0;
#pragma unroll
                for (int bj = 0; bj < 2; ++bj) { f32x4 v0 = acc[ai][bj][m][0] + bv[bj][0], v1 = acc[ai][bj][m][1] + bv[bj][1];
                    if (ACT == 1) { f32x2 a = gelu_pk((f32x2){v0[0], v0[1]}), b = gelu_pk((f32x2){v0[2], v0[3]}), c = gelu_pk((f32x2){v1[0], v1[1]}), d = gelu_pk((f32x2){v1[2], v1[3]});
                        v0 = (f32x4){a.x, a.y, b.x, b.y}; v1 = (f32x4){c.x, c.y, d.x, d.y}; }
                    v0 = v0 * sc; v1 = v1 * sc; u32x4 w; w.x = cvt_pk_bf16(v0[0], v0[1]); w.y = cvt_pk_bf16(v0[2], v0[3]); w.z = cvt_pk_bf16(v1[0], v1[1]); w.w = cvt_pk_bf16(v1[2], v1[3]);
                    *(u32x4*)(rowp + bj * HALF) = w; } }
    }
};

template <class Sink> struct Epi8 {
    static constexpr bool PERM = true, AFTER_DRAIN = false;
    Sink s;
    __device__ __forceinline__ void operator()(const f32x4 (&acc)[2][2][4][2], const Unit& u, int wr, int wc, int fr, int fq) const {
        const int row0 = u.pm * BM + wr * 64 + fr, col0 = u.pn * BM + wc * 32 + 8 * fq;
#pragma unroll
        for (int ai = 0; ai < 2; ++ai)
#pragma unroll
            for (int m = 0; m < 4; ++m)
#pragma unroll
                for (int bj = 0; bj < 2; ++bj) {
                    const f32x4 a0 = acc[ai][bj][m][0], a1 = acc[ai][bj][m][1];
                    const float v[8] = {a0[0], a0[1], a0[2], a0[3], a1[0], a1[1], a1[2], a1[3]};
                    s(row0 + ai * HALF + m * 16, col0 + bj * HALF, v);
                }
    }
};

template <class Epi, class Sched, bool ALIGN_EPI = false, bool SP2 = false>
__device__ __forceinline__ void gemm_phase(PG8_LAS unsigned char* lds, const Gemm g, const Sched& S, const Epi& E) {
    const int tid = threadIdx.x, wid = __builtin_amdgcn_readfirstlane(tid >> 6), lane = tid & 63, wr = wid >> 2, wc = wid & 3, fr = lane & 15, fq = lane >> 4;
    const int K = g.K, nt = K / BK;
    unsigned voffA[2], voffB[2];
#pragma unroll
    for (int i = 0; i < 2; ++i) { int R, C; stage_rc(tid * 16 + i * 8192, R, C); const int Rb = Epi::PERM ? ((R & ~31) + perm32(R & 31)) : R;
        voffA[i] = (unsigned)(R * K + C) * 2u; voffB[i] = (unsigned)(Rb * K + C) * 2u; }
    const size_t kstep = (size_t)(BK * 2);
    const size_t hstep = (size_t)HALF * K * 2;
    const size_t tstep = 2 * hstep;
    const unsigned ldsw = (unsigned)wid * 1024u;
    const int aoff = lds_byte(wr * 64 + fr, fq * 8), boff = lds_byte(wc * 32 + fr, fq * 8);
#define PG8_SA(b, h) (((b) * 2 + (h)) * HTB)
#define PG8_SB(b, h) ((4 + (b) * 2 + (h)) * HTB)
#define PG8_STAGE(bufoff, gbase, voff) do { _Pragma("unroll") for (int _i = 0; _i < 2; ++_i) \
        __builtin_amdgcn_global_load_lds((const unsigned*)((const char*)(gbase) + (voff)[_i]), (PG8_LAS unsigned*)(lds + (bufoff) + ldsw + _i * 8192), 16, 0, 0); } while (0)
#define PG8_LDA(dst, b, h) do { _Pragma("unroll") for (int m = 0; m < 4; ++m) _Pragma("unroll") for (int k = 0; k < 2; ++k) dst[m][k] = *(const PG8_LAS bf16x8*)(lds + PG8_SA(b, h) + aoff + m * 2048 + k * 1024); } while (0)
#define PG8_LDB(dst, b, h) do { _Pragma("unroll") for (int n = 0; n < 2; ++n) _Pragma("unroll") for (int k = 0; k < 2; ++k) dst[n][k] = *(const PG8_LAS bf16x8*)(lds + PG8_SB(b, h) + boff + n * 2048 + k * 1024); } while (0)
#define PG8_MMA(ai, bj, At, Bt) do { __builtin_amdgcn_s_setprio(1); _Pragma("unroll") for (int m = 0; m < 4; ++m) _Pragma("unroll") for (int n = 0; n < 2; ++n) _Pragma("unroll") for (int k = 0; k < 2; ++k) \
        acc[ai][bj][m][n] = __builtin_amdgcn_mfma_f32_16x16x32_bf16(Bt[n][k], At[m][k], acc[ai][bj][m][n], 0, 0, 0); __builtin_amdgcn_s_setprio(0); } while (0)
#define PG8_WAIT_V(n) asm volatile("s_waitcnt vmcnt(" #n ")" ::: "memory")
#define PG8_WAIT_L(n) asm volatile("s_waitcnt lgkmcnt(" #n ")" ::: "memory")
#define PG8_BAR __builtin_amdgcn_s_barrier()
#define PG8_SCHED __builtin_amdgcn_sched_barrier(0)
    Unit cur, nxt; int ui = 0;
    if (!S.next(0, cur)) return;
    f32x4 acc[2][2][4][2];
#pragma unroll
    for (int a = 0; a < 2; ++a)
#pragma unroll
        for (int b = 0; b < 2; ++b)
#pragma unroll
            for (int m = 0; m < 4; ++m)
#pragma unroll
                for (int n = 0; n < 2; ++n) acc[a][b][m][n] = (f32x4){0.f, 0.f, 0.f, 0.f};
    bf16x8 At[4][2], B0[2][2], B1[2][2];
    const char* cA = (const char*)g.A + (size_t)cur.pm * tstep; const char* cB = (const char*)g.Bt + (size_t)cur.pn * tstep;
    S.a_ready(cur);
    if constexpr (SP2) {
        PG8_STAGE(PG8_SB(0, 0), cB, voffB); PG8_STAGE(PG8_SB(0, 1), cB + hstep, voffB); PG8_STAGE(PG8_SA(0, 0), cA, voffA); PG8_STAGE(PG8_SA(0, 1), cA + hstep, voffA);
        if (wr == 1) PG8_BAR;
        PG8_WAIT_V(2); PG8_BAR;
        PG8_STAGE(PG8_SB(1, 0), cB + kstep, voffB); PG8_STAGE(PG8_SA(1, 0), cA + kstep, voffA); PG8_STAGE(PG8_SB(1, 1), cB + hstep + kstep, voffB);
        PG8_WAIT_V(6); PG8_BAR;
    } else {
        PG8_STAGE(PG8_SB(0, 0), cB, voffB); PG8_STAGE(PG8_SA(0, 0), cA, voffA); PG8_STAGE(PG8_SB(0, 1), cB + hstep, voffB); PG8_STAGE(PG8_SA(0, 1), cA + hstep, voffA);
        if (wr == 1) PG8_BAR;
        PG8_WAIT_V(4); PG8_BAR;
        PG8_STAGE(PG8_SB(1, 0), cB + kstep, voffB); PG8_STAGE(PG8_SA(1, 0), cA + kstep, voffA); PG8_STAGE(PG8_SB(1, 1), cB + hstep + kstep, voffB);
        PG8_WAIT_V(6); PG8_BAR;
    }
    for (;;) {
        const bool has_next = S.next(ui + 1, nxt);
        const char* nA = has_next ? (const char*)g.A + (size_t)nxt.pm * tstep : cA; const char* nB = has_next ? (const char*)g.Bt + (size_t)nxt.pn * tstep : cB;
        for (int t = 0; t < nt; t += 2) {
            const bool last = (t == nt - 2);
            const char* a1 = cA + (size_t)(t + 1) * kstep;
            const char* a2 = last ? nA : cA + (size_t)(t + 2) * kstep; const char* b2 = last ? nB : cB + (size_t)(t + 2) * kstep;
            const char* a3 = a2 + kstep; const char* b3 = b2 + kstep;
            if (last && has_next) S.a_ready(nxt);
            if constexpr (SP2) {
            PG8_LDB(B0, 0, 0); PG8_LDB(B1, 0, 1); PG8_SCHED; PG8_LDA(At, 0, 0); PG8_STAGE(PG8_SA(1, 1), a1 + hstep, voffA);
            PG8_WAIT_V(8); PG8_WAIT_L(0); PG8_BAR; PG8_MMA(0, 0, At, B0); PG8_MMA(0, 1, At, B1); PG8_BAR; PG8_SCHED;
            PG8_LDA(At, 0, 1); PG8_STAGE(PG8_SB(0, 0), b2, voffB); PG8_STAGE(PG8_SB(0, 1), b2 + hstep, voffB); PG8_STAGE(PG8_SA(0, 0), a2, voffA);
            PG8_WAIT_V(8); PG8_WAIT_L(0); PG8_BAR; PG8_MMA(1, 0, At, B0); PG8_MMA(1, 1, At, B1); PG8_BAR; PG8_SCHED;
            PG8_LDB(B0, 1, 0); PG8_LDB(B1, 1, 1); PG8_SCHED; PG8_LDA(At, 1, 0); PG8_STAGE(PG8_SA(0, 1), a2 + hstep, voffA);
            PG8_WAIT_V(8); PG8_WAIT_L(0); PG8_BAR; PG8_MMA(0, 0, At, B0); PG8_MMA(0, 1, At, B1); PG8_BAR; PG8_SCHED;
            PG8_LDA(At, 1, 1); PG8_STAGE(PG8_SB(1, 0), b3, voffB); PG8_STAGE(PG8_SB(1, 1), b3 + hstep, voffB); PG8_STAGE(PG8_SA(1, 0), a3, voffA);
            PG8_WAIT_V(8); PG8_WAIT_L(0); PG8_BAR; PG8_MMA(1, 0, At, B0); PG8_MMA(1, 1, At, B1); PG8_BAR; PG8_SCHED;
            } else {
            PG8_LDB(B0, 0, 0); PG8_SCHED; PG8_LDA(At, 0, 0); PG8_STAGE(PG8_SA(1, 1), a1 + hstep, voffA);
            PG8_WAIT_L(8); PG8_BAR; PG8_WAIT_L(0); PG8_MMA(0, 0, At, B0); PG8_BAR; PG8_SCHED;
            PG8_LDB(B1, 0, 1); PG8_STAGE(PG8_SB(0, 0), b2, voffB);
            PG8_BAR; PG8_WAIT_L(0); PG8_MMA(0, 1, At, B1); PG8_BAR;
            PG8_LDA(At, 0, 1); PG8_STAGE(PG8_SA(0, 0), a2, voffA);
            PG8_BAR; PG8_WAIT_L(0); PG8_MMA(1, 0, At, B0); PG8_BAR; PG8_SCHED;
            PG8_STAGE(PG8_SB(0, 1), b2 + hstep, voffB);
            PG8_WAIT_V(6); PG8_BAR; PG8_MMA(1, 1, At, B1); PG8_BAR;
            PG8_LDB(B0, 1, 0); PG8_SCHED; PG8_LDA(At, 1, 0); PG8_STAGE(PG8_SA(0, 1), a2 + hstep, voffA);
            PG8_WAIT_L(8); PG8_BAR; PG8_WAIT_L(0); PG8_MMA(0, 0, At, B0); PG8_BAR; PG8_SCHED;
            PG8_LDB(B1, 1, 1); PG8_STAGE(PG8_SB(1, 0), b3, voffB);
            PG8_BAR; PG8_WAIT_L(0); PG8_MMA(0, 1, At, B1); PG8_BAR;
            PG8_LDA(At, 1, 1); PG8_STAGE(PG8_SA(1, 0), a3, voffA);
            PG8_BAR; PG8_WAIT_L(0); PG8_MMA(1, 0, At, B0); PG8_BAR; PG8_SCHED;
            PG8_STAGE(PG8_SB(1, 1), b3 + hstep, voffB);
            PG8_WAIT_V(6); PG8_BAR; PG8_MMA(1, 1, At, B1); PG8_BAR;
            }
        }
        if constexpr (ALIGN_EPI) { if (wr == 0) PG8_BAR; }
        if constexpr (!Epi::AFTER_DRAIN) { E(acc, cur, wr, wc, fr, fq); S.done(cur); }
        if (!has_next) break;
#pragma unroll
        for (int a = 0; a < 2; ++a)
#pragma unroll
            for (int b = 0; b < 2; ++b)
#pragma unroll
                for (int m = 0; m < 4; ++m)
#pragma unroll
                    for (int n = 0; n < 2; ++n) acc[a][b][m][n] = (f32x4){0.f, 0.f, 0.f, 0.f};
        cur = nxt; cA = nA; cB = nB; ++ui;
        if constexpr (ALIGN_EPI) { if (wr == 1) PG8_BAR; }
    }
    PG8_WAIT_V(0);
    if constexpr (!ALIGN_EPI) { if (wr == 0) PG8_BAR; }
    PG8_BAR;
    if constexpr (Epi::AFTER_DRAIN) { E.fused(acc, cur, wr, wc, fr, fq, lds, wid, lane); S.done(cur); }
#undef PG8_SA
#undef PG8_SB
#undef PG8_STAGE
#undef PG8_LDA
#undef PG8_LDB
#undef PG8_MMA
#undef PG8_WAIT_V
#undef PG8_WAIT_L
#undef PG8_BAR
#undef PG8_SCHED
}
}

#ifndef PG8_SP2
#define PG8_SP2 true
#endif
#ifndef PG8_ALIGN
#define PG8_ALIGN true
#endif

#define GAS __attribute__((address_space(1)))
#define LAS __attribute__((address_space(3)))
typedef unsigned short bf16;
typedef unsigned v4u __attribute__((ext_vector_type(4)));
typedef float f32x4 __attribute__((ext_vector_type(4)));
typedef short bf16x8 __attribute__((ext_vector_type(8)));
typedef GAS unsigned gu32;
typedef GAS unsigned long long gu64;
#define RLX_AGENT __ATOMIC_RELAXED, __HIP_MEMORY_SCOPE_AGENT
#define LDS_WAIT() asm volatile("s_waitcnt lgkmcnt(0)" ::: "memory")
#define VM_WAIT() asm volatile("s_waitcnt vmcnt(0)" ::: "memory")
__device__ __forceinline__ unsigned long long rt() { return __builtin_amdgcn_s_memrealtime(); }
__device__ __forceinline__ unsigned f2bf(float f) { unsigned u = __builtin_bit_cast(unsigned, f); return (u + 0x7fffu + ((u >> 16) & 1u)) >> 16; }
__device__ __forceinline__ unsigned pk2(float lo, float hi) { return f2bf(lo) | (f2bf(hi) << 16); }

#define XB_TMO      128
#define XB_XCNT(j)  (256  + 64 * (j))
#define XB_XSUB(j)  (1280 + 64 * (j))
#define XB_XGEN(j)  (2304 + 64 * (j))
#define XB_TOP      3328
#define XB_TOPGEN   3392
#define XCD_BAR_WORDS 3456
#define XB_SPIN_CAP (1u << 18)

__device__ __forceinline__ unsigned xb_ld(unsigned* p)              { return __hip_atomic_load(p, __ATOMIC_RELAXED, __HIP_MEMORY_SCOPE_AGENT); }
__device__ __forceinline__ unsigned xb_add(unsigned* p, unsigned v) { return __hip_atomic_fetch_add(p, v, __ATOMIC_RELAXED, __HIP_MEMORY_SCOPE_AGENT); }
__device__ __forceinline__ unsigned xb_xcc_id() { return (unsigned)__builtin_amdgcn_s_getreg((3 << 11) | 20) & 0xFu; }
#define XB_SPIN(cond, bar) do { unsigned _sp = 0; while (cond) { __builtin_amdgcn_s_sleep(1); \
    if ((++_sp & 255u) == 0u) { if (xb_ld(&(bar)[XB_TMO])) break; if (_sp > XB_SPIN_CAP) { atomicAdd(&(bar)[XB_TMO], 1u); break; } } } } while (0)

struct XcdBarrier {
    unsigned* bar; unsigned x;
    volatile LAS unsigned* st;
};

__device__ __forceinline__ XcdBarrier xcd_barrier_post(unsigned* bar, volatile LAS unsigned* st) {
    XcdBarrier b; b.bar = bar; b.x = xb_xcc_id(); b.st = st;
    if (threadIdx.x == 0) (void)xb_add(&bar[XB_XCNT(b.x)], 1u);
    return b;
}
__device__ __forceinline__ void xcd_barrier_complete(unsigned* bar, unsigned x, unsigned& nloc, unsigned& nx) {
    const unsigned G = gridDim.x * gridDim.y * gridDim.z;
    unsigned sum, cnt, mine, sp = 0u;
    for (;;) {
        sum = 0u; cnt = 0u; mine = 0u;
#pragma unroll
        for (unsigned j = 0; j < 16; ++j) { const unsigned c = xb_ld(&bar[XB_XCNT(j)]); sum += c; cnt += (c > 0u) ? 1u : 0u; mine = (j == x) ? c : mine; }
        if (sum == G) break;
        __builtin_amdgcn_s_sleep(1);
        if ((++sp & 255u) == 0u) { if (xb_ld(&bar[XB_TMO])) break; if (sp > XB_SPIN_CAP) { atomicAdd(&bar[XB_TMO], 1u); break; } }
    }
    nloc = mine > 0u ? mine : 1u; nx = cnt > 0u ? cnt : 1u;
}

__device__ __forceinline__ void xcd_barrier(const XcdBarrier& b) {
    asm volatile("s_waitcnt vmcnt(0)" ::: "memory");
    __syncthreads();
    if (threadIdx.x == 0) {
        unsigned* bar = b.bar;
        __builtin_amdgcn_s_waitcnt(0);
        unsigned nloc = b.st[0], nx = b.st[1];
        if (nloc == 0u) { xcd_barrier_complete(bar, b.x, nloc, nx); b.st[0] = nloc; b.st[1] = nx; }
        const unsigned old = xb_add(&bar[XB_XSUB(b.x)], 1u);
        const unsigned gen = old / nloc;
        if (old + 1u == (gen + 1u) * nloc) {
            __builtin_amdgcn_fence(__ATOMIC_RELEASE, "agent");
            asm volatile("s_waitcnt vmcnt(0)" ::: "memory");
            const unsigned og = xb_add(&bar[XB_TOP], 1u);
            const unsigned tg = og / nx;
            if (og + 1u == (tg + 1u) * nx) xb_add(&bar[XB_TOPGEN], 1u);
            else XB_SPIN(xb_ld(&bar[XB_TOPGEN]) == tg, bar);
            __builtin_amdgcn_fence(__ATOMIC_ACQUIRE, "agent");
            xb_add(&bar[XB_XGEN(b.x)], 1u);
            asm volatile("s_waitcnt vmcnt(0)" ::: "memory");
        } else {
            XB_SPIN(xb_ld(&bar[XB_XGEN(b.x)]) == gen, bar);
            __builtin_amdgcn_fence(__ATOMIC_ACQUIRE, "agent");
            asm volatile("s_waitcnt vmcnt(0)" ::: "memory");
        }
    }
    __syncthreads();
}

constexpr int NWAVES = 8, NTHR = 512;
constexpr int DM = 2048, NTOK = 8192, SEQ = 4096;
constexpr int DS5 = 1024, NGRP = 64, GH = 16, NST = 64;
constexpr int NHEAD = 4, GDK = 512, GDV = 1024, HK = 128, HV = 256, RANK = 16, CHUNK = 64, NCHUNK = 64;
constexpr int DIN = 5136, DINP = 5376;
constexpr float EPS = 1e-6f;
enum { I_X = 0, I_PREW, I_WIN, I_ARE, I_AIM, I_BRE, I_BIM, I_CRE, I_CIM, I_D, I_LOGDT, I_GLUW, I_GLUB, I_GUP, I_GBIAS, I_GNORM, I_WOUT, I_POSTW, N_IN };

constexpr size_t MiB = 1u << 20;
constexpr size_t WS_CTL = 0, CTL_ZERO_BYTES = 65536;
constexpr size_t WS_WIN = 1 * MiB;
constexpr size_t WS_WGLU = 22 * MiB;
constexpr size_t WS_WOUT = 24 * MiB;
constexpr size_t WS_XN = 32 * MiB;
constexpr size_t WS_KVT = 32 * MiB;
constexpr size_t WS_CONCAT = 32 * MiB;
constexpr size_t WS_UT = 64 * MiB;
constexpr size_t WS_ZS5 = 80 * MiB;
constexpr size_t WS_MIXED = 64 * MiB;
constexpr size_t WS_Q = 96 * MiB;
constexpr size_t WS_K = 104 * MiB;
constexpr size_t WS_V = 112 * MiB;
constexpr size_t WS_ZGLA = 128 * MiB;
constexpr size_t WS_GLOW = 144 * MiB;
constexpr size_t WS_DEC = 145 * MiB;
constexpr size_t WS_SLOC = 146 * MiB;
constexpr size_t WS_KT = 150 * MiB;
constexpr size_t WS_AT = 153 * MiB;
constexpr size_t WS_W1 = 154 * MiB;
constexpr size_t WS_W2 = 170 * MiB;
constexpr size_t WS_YPRE = 186 * MiB;
constexpr size_t WS_SPT = 202 * MiB;
constexpr size_t WS_END = 234 * MiB;
constexpr int CW_BAR = 4096;

constexpr int RING_OFF = 0, RING_BYTES = 131072;
constexpr int LDSCTL_OFF = RING_BYTES, MISC_OFF = LDSCTL_OFF + 320;
constexpr int LDS_BYTES = 147456;

struct Args { const float* in[N_IN]; float* out; unsigned char* ws; int ph_lo, ph_hi; };
static_assert(sizeof(Args) == N_IN * 8 + 8 + 8 + 8, "Args has no padding");

struct Frame {
    LAS unsigned char* lds; volatile LAS unsigned* MISC; gu32* ctl;
    int tid, lane, wave, vcu, G;
};

__device__ __forceinline__ float wave_sum(float v) {
#pragma unroll
    for (int o = 1; o < 64; o <<= 1) v += __shfl_xor(v, o);
    return v;
}
__device__ __forceinline__ float bf2f(unsigned short b) { return __builtin_bit_cast(float, ((unsigned)b) << 16); }
__device__ __forceinline__ void store8bf(bf16* p, const float (&v)[8]) {
    v4u w; w.x = pg8::cvt_pk_bf16(v[0], v[1]); w.y = pg8::cvt_pk_bf16(v[2], v[3]); w.z = pg8::cvt_pk_bf16(v[4], v[5]); w.w = pg8::cvt_pk_bf16(v[6], v[7]);
    *(v4u*)p = w;
}
__device__ __forceinline__ void load8bf(const bf16* p, float (&v)[8]) {
    const v4u w = *(const v4u*)p;
    v[0] = __builtin_bit_cast(float, w.x << 16); v[1] = __builtin_bit_cast(float, w.x & 0xffff0000u);
    v[2] = __builtin_bit_cast(float, w.y << 16); v[3] = __builtin_bit_cast(float, w.y & 0xffff0000u);
    v[4] = __builtin_bit_cast(float, w.z << 16); v[5] = __builtin_bit_cast(float, w.z & 0xffff0000u);
    v[6] = __builtin_bit_cast(float, w.w << 16); v[7] = __builtin_bit_cast(float, w.w & 0xffff0000u);
}
__device__ __forceinline__ float sigmoidf_(float x) { return 1.0f / (1.0f + __expf(-x)); }
__device__ __forceinline__ float siluf_(float x) { return x * sigmoidf_(x); }
__device__ __forceinline__ float gelu_tanh(float x) {
    const float z = 0.7978845608028654f * (x + 0.044715f * x * x * x);
    const float t = 1.0f - 2.0f / (1.0f + __expf(2.0f * z));
    return 0.5f * x * (1.0f + t);
}
__device__ __forceinline__ float log_sigmoid(float z) { return fminf(z, 0.f) - log1pf(__expf(-fabsf(z))); }
__device__ __forceinline__ void cexp_dt(float ar, float ai, float dt, float mult, float& re, float& im) {
    const double th = (double)ai * (double)dt * (double)mult;
    const double k = __builtin_rint(th * 0.15915494309189535);
    const float r = (float)(th - k * 6.283185307179586);
    const float mag = expf(ar * dt * mult);
    re = mag * cosf(r); im = mag * sinf(r);
}

struct ProjSink {
    bf16 *UT, *ZS5, *Q, *K, *V, *ZGLA; float* GLOW;
    __device__ __forceinline__ void operator()(int row, int c0, const float (&v)[8]) const {
        if (c0 < 1024) { const int g = c0 >> 4; store8bf(UT + ((size_t)g * NTOK + row) * 16 + (c0 & 15), v); }
        else if (c0 < 2048) { float o[8];
#pragma unroll
            for (int i = 0; i < 8; ++i) o[i] = siluf_(v[i]);
            store8bf(ZS5 + (size_t)row * 1024 + (c0 - 1024), o); }
        else if (c0 < 2560) { float o[8];
#pragma unroll
            for (int i = 0; i < 8; ++i) o[i] = v[i] * 0.08838834764831845f;
            store8bf(Q + (size_t)row * 512 + (c0 - 2048), o); }
        else if (c0 < 3072) store8bf(K + (size_t)row * 512 + (c0 - 2560), v);
        else if (c0 < 4096) store8bf(V + (size_t)row * 1024 + (c0 - 3072), v);
        else if (c0 < 5120) { float o[8];
#pragma unroll
            for (int i = 0; i < 8; ++i) o[i] = siluf_(v[i]);
            store8bf(ZGLA + (size_t)row * 1024 + (c0 - 4096), o); }
        else if (c0 < DIN) { float* p = GLOW + (size_t)row * 16 + (c0 - 5120);
            *(f32x4*)p = (f32x4){v[0], v[1], v[2], v[3]}; *(f32x4*)(p + 4) = (f32x4){v[4], v[5], v[6], v[7]}; }
    }
};
struct GluSink {
    const bf16 *YPRE, *ZS5; const float* glub; bf16* CONCAT;
    __device__ __forceinline__ void operator()(int row, int c0, const float (&v)[8]) const {
        float y[8], g[8], o[8]; load8bf(YPRE + (size_t)row * 1024 + c0, y); load8bf(ZS5 + (size_t)row * 1024 + c0, g);
        const f32x4 b0 = *(const f32x4*)(glub + c0), b1 = *(const f32x4*)(glub + c0 + 4);
        const float b[8] = {b0[0], b0[1], b0[2], b0[3], b1[0], b1[1], b1[2], b1[3]};
#pragma unroll
        for (int i = 0; i < 8; ++i) o[i] = y[i] * sigmoidf_(v[i] + b[i]) * g[i];
        store8bf(CONCAT + (size_t)row * 2048 + c0, o);
    }
};
struct MixSink {
    bf16* MIXED;
    __device__ __forceinline__ void operator()(int row, int c0, const float (&v)[8]) const { store8bf(MIXED + (size_t)row * 2048 + c0, v); }
};

template <class Sink> __device__ __forceinline__ void naive_gemm(const bf16* A, const bf16* Bt, int M, int N, int K, const Sink& s, int gtid, int gthreads) {
    const int n8 = N / 8; const long total = (long)M * n8;
    for (long it = gtid; it < total; it += gthreads) {
        const int c0 = (int)(it % n8) * 8, row = (int)(it / n8);
        float acc[8] = {0.f, 0.f, 0.f, 0.f, 0.f, 0.f, 0.f, 0.f};
        for (int k = 0; k < K; k += 8) {
            float a[8]; load8bf(A + (size_t)row * K + k, a);
#pragma unroll
            for (int i = 0; i < 8; ++i) { float b[8]; load8bf(Bt + (size_t)(c0 + i) * K + k, b);
#pragma unroll
                for (int j = 0; j < 8; ++j) acc[i] += a[j] * b[j]; }
        }
        s(row, c0, acc);
    }
}

__device__ __forceinline__ void p0_transpose_item(const float* W, int K, int N, int Npad, bf16* WT, LAS float* scr, int item, int lane) {
    const int nblk = Npad / 32, kb = item / nblk, nb = item % nblk, k0 = 64 * kb, n0 = 32 * nb;
    const int nl = n0 + (lane & 31); const bool ok = nl < N;
#pragma unroll 8
    for (int i = 0; i < 32; ++i) { const int kk = 2 * i + (lane >> 5); scr[kk * 33 + (lane & 31)] = ok ? W[(size_t)(k0 + kk) * N + nl] : 0.f; }
    LDS_WAIT(); asm volatile("" ::: "memory");
    const int c = lane & 7;
#pragma unroll
    for (int j = 0; j < 4; ++j) { const int n = (lane >> 3) + 8 * j; const LAS float* s = scr + (8 * c) * 33 + n;
        v4u o; o.x = pg8::cvt_pk_bf16(s[0 * 33], s[1 * 33]); o.y = pg8::cvt_pk_bf16(s[2 * 33], s[3 * 33]); o.z = pg8::cvt_pk_bf16(s[4 * 33], s[5 * 33]); o.w = pg8::cvt_pk_bf16(s[6 * 33], s[7 * 33]);
        *(v4u*)(WT + (size_t)(n0 + n) * K + k0 + 8 * c) = o; }
    LDS_WAIT(); asm volatile("" ::: "memory");
}
__device__ __forceinline__ void p0_xn_row(const float* xrow, const float* w, bf16* orow, int lane) {
    const f32x4* xr = (const f32x4*)xrow + lane; const f32x4* wr = (const f32x4*)w + lane;
    f32x4 v[8]; float s = 0.f;
#pragma unroll
    for (int j = 0; j < 8; ++j) { v[j] = xr[64 * j]; s += (v[j].x * v[j].x + v[j].y * v[j].y) + (v[j].z * v[j].z + v[j].w * v[j].w); }
    const float rstd = 1.0f / sqrtf(wave_sum(s) * (1.0f / DM) + EPS);
    unsigned long long* o8 = (unsigned long long*)orow + lane;
#pragma unroll
    for (int j = 0; j < 8; ++j) { const f32x4 wv = wr[64 * j]; const f32x4 o = v[j] * rstd * wv;
        o8[64 * j] = (unsigned long long)pg8::cvt_pk_bf16(o.x, o.y) | ((unsigned long long)pg8::cvt_pk_bf16(o.z, o.w) << 32); }
}
__device__ __forceinline__ void p0_prologue(const Frame& F, const Args& a) {
    LAS float* scr = (LAS float*)(F.lds + RING_OFF + F.wave * 16384);
    const int gw = F.vcu * NWAVES + F.wave, NGW = F.G * NWAVES;
    constexpr int I_IN = (DM / 64) * (DINP / 32), I_GLU = (DS5 / 64) * (DS5 / 32), I_OUT = (DM / 64) * (DM / 32);
    constexpr int NITEMS = I_IN + I_GLU + I_OUT;
    for (int it = gw; it < NITEMS; it += NGW) {
        int r = it;
        if (r < I_IN) { p0_transpose_item(a.in[I_WIN], DM, DIN, DINP, (bf16*)(a.ws + WS_WIN), scr, r, F.lane); continue; } r -= I_IN;
        if (r < I_GLU) { p0_transpose_item(a.in[I_GLUW], DS5, DS5, DS5, (bf16*)(a.ws + WS_WGLU), scr, r, F.lane); continue; } r -= I_GLU;
        p0_transpose_item(a.in[I_WOUT], DM, DM, DM, (bf16*)(a.ws + WS_WOUT), scr, r, F.lane);
    }
    for (int m = gw; m < NTOK; m += NGW) p0_xn_row(a.in[I_X] + (size_t)m * DM, a.in[I_PREW], (bf16*)(a.ws + WS_XN) + (size_t)m * DM, F.lane);
}

__device__ __forceinline__ void s5_naive_item(const Args& a, int item, int lane) {
    const int b = item / NGRP, g = item % NGRP, p = lane;
    const float ar = fminf(a.in[I_ARE][g * NST + p], -1e-4f), ai = a.in[I_AIM][g * NST + p];
    const float dt = expf(a.in[I_LOGDT][g]);
    float abr, abi; cexp_dt(ar, ai, dt, 1.0f, abr, abi);
    const float xr = abr - 1.0f, xi = abi, den = 1.0f / (ar * ar + ai * ai);
    const float cr = (xr * ar + xi * ai) * den, ci = (xi * ar - xr * ai) * den;
    float Bbr[GH], Bbi[GH], Ccr[GH], Cci[GH], Dv[GH];
#pragma unroll
    for (int h = 0; h < GH; ++h) {
        const float br = a.in[I_BRE][(g * NST + p) * GH + h], bi = a.in[I_BIM][(g * NST + p) * GH + h];
        Bbr[h] = cr * br - ci * bi; Bbi[h] = cr * bi + ci * br;
        Ccr[h] = a.in[I_CRE][(g * GH + h) * NST + p]; Cci[h] = a.in[I_CIM][(g * GH + h) * NST + p];
        Dv[h] = a.in[I_D][g * GH + h];
    }
    const bf16* U = (const bf16*)(a.ws + WS_UT) + ((size_t)g * NTOK + (size_t)b * SEQ) * 16;
    bf16* Y = (bf16*)(a.ws + WS_YPRE) + (size_t)b * SEQ * DS5 + g * GH;
    float sr = 0.f, si = 0.f;
    for (int t = 0; t < SEQ; ++t) {
        float u[16]; { float u0[8], u1[8]; load8bf(U + (size_t)t * 16, u0); load8bf(U + (size_t)t * 16 + 8, u1);
#pragma unroll
            for (int i = 0; i < 8; ++i) { u[i] = u0[i]; u[8 + i] = u1[i]; } }
        float bur = 0.f, bui = 0.f;
#pragma unroll
        for (int h = 0; h < GH; ++h) { bur += Bbr[h] * u[h]; bui += Bbi[h] * u[h]; }
        const float nr = abr * sr - abi * si + bur, ni = abr * si + abi * sr + bui; sr = nr; si = ni;
        float mine = 0.f;
#pragma unroll
        for (int h = 0; h < GH; ++h) { const float y = wave_sum(Ccr[h] * sr - Cci[h] * si) + Dv[h] * u[h]; mine = (lane == h) ? y : mine; }
        if (lane < GH) { const float o = gelu_tanh(mine); Y[(size_t)t * DS5 + lane] = (bf16)(pg8::cvt_pk_bf16(o, 0.f) & 0xffffu); }
    }
}

__device__ __forceinline__ void gla_naive_item(const Frame& F, const Args& a, int item) {
    const int b = item / NHEAD, h = item % NHEAD, tid = F.tid, dv = tid & 255, half = tid >> 8;
    LAS float* qs = (LAS float*)(F.lds + RING_OFF); LAS float* ks = qs + 128; LAS float* gs = ks + 128; LAS float* part = gs + 128; LAS float* red = part + 512;
    float S[64];
#pragma unroll
    for (int j = 0; j < 64; ++j) S[j] = 0.f;
    float gu[RANK]; float gb = 0.f;
    if (tid < HK) {
#pragma unroll
        for (int r = 0; r < RANK; ++r) gu[r] = a.in[I_GUP][r * GDK + h * HK + tid];
        gb = a.in[I_GBIAS][h * HK + tid];
    } else {
#pragma unroll
        for (int r = 0; r < RANK; ++r) gu[r] = 0.f;
    }
    const float nw = a.in[I_GNORM][dv];
    const bf16* Q = (const bf16*)(a.ws + WS_Q); const bf16* K = (const bf16*)(a.ws + WS_K); const bf16* V = (const bf16*)(a.ws + WS_V);
    const bf16* ZG = (const bf16*)(a.ws + WS_ZGLA); const float* GL = (const float*)(a.ws + WS_GLOW); bf16* CC = (bf16*)(a.ws + WS_CONCAT);
    for (int t = 0; t < SEQ; ++t) {
        const size_t tok = (size_t)b * SEQ + t;
        if (tid < HK) {
            float z = gb;
#pragma unroll
            for (int r = 0; r < RANK; ++r) z += GL[tok * 16 + r] * gu[r];
            gs[tid] = __expf(log_sigmoid(z) * (1.0f / 16.0f));
            qs[tid] = bf2f(Q[tok * GDK + h * HK + tid]); ks[tid] = bf2f(K[tok * GDK + h * HK + tid]);
        }
        __syncthreads();
        const float v = bf2f(V[tok * GDV + h * HV + dv]);
        float o = 0.f;
#pragma unroll
        for (int j = 0; j < 64; ++j) { const int dk = half * 64 + j; S[j] = gs[dk] * S[j] + ks[dk] * v; o += qs[dk] * S[j]; }
        part[tid] = o;
        __syncthreads();
        float ot = 0.f;
        if (half == 0) { ot = part[dv] + part[256 + dv]; const float ss = wave_sum(ot * ot); if (F.lane == 0) red[F.wave] = ss; }
        __syncthreads();
        if (half == 0) { const float tot = (red[0] + red[1]) + (red[2] + red[3]); const float rstd = 1.0f / sqrtf(tot * (1.0f / HV) + EPS);
            const float res = ot * rstd * nw * bf2f(ZG[tok * GDV + h * HV + dv]);
            CC[tok * 2048 + 1024 + h * HV + dv] = (bf16)(pg8::cvt_pk_bf16(res, 0.f) & 0xffffu); }
        __syncthreads();
    }
}

__device__ __forceinline__ void p6_row(const float* xrow, const bf16* mrow, const float* pw, float* orow, int lane) {
    float m[4][8]; float s = 0.f;
#pragma unroll
    for (int j = 0; j < 4; ++j) { load8bf(mrow + (size_t)(lane + 64 * j) * 8, m[j]);
#pragma unroll
        for (int i = 0; i < 8; ++i) s += m[j][i] * m[j][i]; }
    const float rstd = 1.0f / sqrtf(wave_sum(s) * (1.0f / DM) + EPS);
#pragma unroll
    for (int j = 0; j < 4; ++j) { const int c = (lane + 64 * j) * 8;
#pragma unroll
        for (int q = 0; q < 2; ++q) { const f32x4 xv = *(const f32x4*)(xrow + c + 4 * q), wv = *(const f32x4*)(pw + c + 4 * q);
            const f32x4 mv = (f32x4){m[j][4 * q], m[j][4 * q + 1], m[j][4 * q + 2], m[j][4 * q + 3]};
            *(f32x4*)(orow + c + 4 * q) = xv + mv * rstd * wv; } }
}

typedef float f32x16 __attribute__((ext_vector_type(16)));
#define MFMA32(a, b, c) __builtin_amdgcn_mfma_f32_32x32x16_bf16((a), (b), (c), 0, 0, 0)
__device__ __forceinline__ f32x16 zero16() { f32x16 z;
#pragma unroll
    for (int i = 0; i < 16; ++i) z[i] = 0.f;
    return z; }
__device__ __forceinline__ bf16x8 pack_step(const f32x16& x, int s) {
    v4u p;
    asm volatile("s_nop 11\n\tv_cvt_pk_bf16_f32 %0, %4, %5\n\tv_cvt_pk_bf16_f32 %1, %6, %7\n\tv_cvt_pk_bf16_f32 %2, %8, %9\n\tv_cvt_pk_bf16_f32 %3, %10, %11\n\ts_nop 1"
                 : "=&v"(p[0]), "=&v"(p[1]), "=&v"(p[2]), "=&v"(p[3])
                 : "v"(x[8 * s]), "v"(x[8 * s + 1]), "v"(x[8 * s + 2]), "v"(x[8 * s + 3]), "v"(x[8 * s + 4]), "v"(x[8 * s + 5]), "v"(x[8 * s + 6]), "v"(x[8 * s + 7]));
    return __builtin_bit_cast(bf16x8, p);
}
__device__ __forceinline__ unsigned short f2bf16(float f) { return (unsigned short)f2bf(f); }

__device__ __forceinline__ void s5_tables(const Frame& F, const Args& a, int g, int qt) {
    LAS float* APr = (LAS float*)(F.lds + RING_OFF); LAS float* APi = APr + 64 * 65;
    LAS float* BBr = APi + 64 * 65; LAS float* BBi = BBr + 1024; LAS float* CCr = BBi + 1024; LAS float* CCi = CCr + 1024;
    const int tid = F.tid;
    const float dt = expf(a.in[I_LOGDT][g]);
    if (tid < 64) {
        const int p = tid;
        const float ar = fminf(a.in[I_ARE][g * NST + p], -1e-4f), ai = a.in[I_AIM][g * NST + p];
        float abr, abi; cexp_dt(ar, ai, dt, 1.0f, abr, abi);
        const float xr = abr - 1.0f, xi = abi, den = 1.0f / (ar * ar + ai * ai);
        const float cr = (xr * ar + xi * ai) * den, ci = (xi * ar - xr * ai) * den;
#pragma unroll
        for (int h = 0; h < GH; ++h) { const float br = a.in[I_BRE][(g * NST + p) * GH + h], bi = a.in[I_BIM][(g * NST + p) * GH + h];
            BBr[p * 16 + h] = cr * br - ci * bi; BBi[p * 16 + h] = cr * bi + ci * br; }
    }
    for (int i = tid; i < 1024; i += NTHR) { CCr[i] = a.in[I_CRE][g * 1024 + i]; CCi[i] = a.in[I_CIM][g * 1024 + i]; }
    for (int i = tid; i < 64 * 65; i += NTHR) { const int p = i / 65, d = i - p * 65;
        const float ar = fminf(a.in[I_ARE][g * NST + p], -1e-4f), ai = a.in[I_AIM][g * NST + p];
        float r, im; cexp_dt(ar, ai, dt, (float)d, r, im); APr[i] = r; APi[i] = im; }
    __syncthreads();
    { bf16* W2 = (bf16*)(a.ws + WS_W2) + (size_t)g * 1024 * 128;
      for (int it = tid; it < 256 * 16; it += NTHR) { const int row = qt * 256 + (it >> 4), cg = it & 15, t = row >> 4, h = row & 15, ri = cg >> 3, p0 = (cg & 7) * 8;
        float o[8];
#pragma unroll
        for (int e = 0; e < 8; ++e) { const int p = p0 + e; const float cr = CCr[h * 64 + p], ci = CCi[h * 64 + p], pr = APr[p * 65 + t + 1], pi = APi[p * 65 + t + 1];
            o[e] = ri == 0 ? (cr * pr - ci * pi) : -(cr * pi + ci * pr); }
        store8bf(W2 + (size_t)row * 128 + cg * 8, o); } }
    { bf16* KT = (bf16*)(a.ws + WS_KT) + (size_t)g * 65 * 256;
      { const int it = tid; const int d = qt * 16 + (it >> 5), h = (it >> 1) & 15, hh = it & 1;
        float acc[8] = {0.f, 0.f, 0.f, 0.f, 0.f, 0.f, 0.f, 0.f};
        for (int p = 0; p < 64; ++p) { const float cr = CCr[h * 64 + p], ci = CCi[h * 64 + p], pr = APr[p * 65 + d], pi = APi[p * 65 + d];
            const float gr = cr * pr - ci * pi, gi = cr * pi + ci * pr;
#pragma unroll
            for (int e = 0; e < 8; ++e) acc[e] += gr * BBr[p * 16 + 8 * hh + e] - gi * BBi[p * 16 + 8 * hh + e]; }
        store8bf(KT + (size_t)(d + 1) * 256 + h * 16 + 8 * hh, acc); }
      if (qt == 0 && tid < 32) { const float z[8] = {0.f, 0.f, 0.f, 0.f, 0.f, 0.f, 0.f, 0.f}; store8bf(KT + tid * 8, z); } }
    { bf16* W1 = (bf16*)(a.ws + WS_W1) + (size_t)g * 128 * 1024;
      for (int it = tid; it < 32 * 64; it += NTHR) { const int row = qt * 32 + (it >> 6), j = it & 63, p = row & 63, ri = row >> 6;
        const float pr = APr[p * 65 + 63 - j], pi = APi[p * 65 + 63 - j];
        float o0[8], o1[8];
#pragma unroll
        for (int e = 0; e < 8; ++e) { const float b0r = BBr[p * 16 + e], b0i = BBi[p * 16 + e], b1r = BBr[p * 16 + 8 + e], b1i = BBi[p * 16 + 8 + e];
            o0[e] = ri == 0 ? (pr * b0r - pi * b0i) : (pr * b0i + pi * b0r); o1[e] = ri == 0 ? (pr * b1r - pi * b1i) : (pr * b1i + pi * b1r); }
        store8bf(W1 + (size_t)row * 1024 + j * 16, o0); store8bf(W1 + (size_t)row * 1024 + j * 16 + 8, o1); } }
    if (qt == 0 && tid < 64) { float* AT = (float*)(a.ws + WS_AT) + (size_t)(g * 64 + tid) * 2; AT[0] = APr[tid * 65 + 64]; AT[1] = APi[tid * 65 + 64]; }
    __syncthreads();
}

__device__ __forceinline__ void s5_sloc_item(const Frame& F, const Args& a, int item) {
    const int g = item >> 1, b = item & 1, w = F.wave, mt = w >> 1, nt = w & 1, lane = F.lane, r = lane & 31, hf = lane >> 5;
    const bf16* U = (const bf16*)(a.ws + WS_UT) + ((size_t)g * NTOK + (size_t)b * SEQ + (size_t)(nt * 32 + r) * 64) * 16 + 8 * hf;
    const bf16* W1 = (const bf16*)(a.ws + WS_W1) + ((size_t)g * 128 + mt * 32 + r) * 1024 + 8 * hf;
    f32x16 acc = zero16();
#pragma unroll 8
    for (int ks = 0; ks < 64; ++ks) {
        const bf16x8 av = *(const bf16x8*)(U + ks * 16), bv = *(const bf16x8*)(W1 + ks * 16);
        acc = MFMA32(av, bv, acc);
    }
    float* SL = (float*)(a.ws + WS_SLOC) + ((size_t)g * 128 + b * 64 + nt * 32) * 128 + mt * 32 + r;
#pragma unroll
    for (int rr = 0; rr < 16; ++rr) { const int nl = (rr & 3) + 8 * (rr >> 2) + 4 * hf; SL[(size_t)nl * 128] = acc[rr]; }
}

constexpr int S5_KTL = 0, S5_UL = 33280, S5_ULROW = 2064, S5_SPL = S5_UL + 32 * S5_ULROW, S5_SPROW = 272;
__device__ __forceinline__ void s5_main_item(const Frame& F, const Args& a, int item) {
    const int g = item >> 2, b = (item >> 1) & 1, nt = item & 1, tid = F.tid, w = F.wave, lane = F.lane, r = lane & 31, hf = lane >> 5;
    LAS unsigned char* L = F.lds + RING_OFF;
    { const v4u* src = (const v4u*)((const bf16*)(a.ws + WS_KT) + (size_t)g * 65 * 256);
      for (int i = tid; i < 2080; i += NTHR) *(LAS v4u*)(L + S5_KTL + i * 16) = src[i];
      const v4u* us = (const v4u*)((const bf16*)(a.ws + WS_UT) + ((size_t)g * NTOK + (size_t)b * SEQ + (size_t)nt * 32 * 64) * 16);
#pragma unroll
      for (int i = 0; i < 8; ++i) { const int idx = tid + NTHR * i, row = idx >> 7, c16 = idx & 127; *(LAS v4u*)(L + S5_UL + row * S5_ULROW + c16 * 16) = us[idx]; } }
    if (w == 0) {
        const float* SL = (const float*)(a.ws + WS_SLOC) + ((size_t)g * 128 + b * 64) * 128 + lane;
        const float* AT = (const float*)(a.ws + WS_AT) + (size_t)(g * 64 + lane) * 2; const float atr = AT[0], ati = AT[1];
        float sr = 0.f, si = 0.f;
        const int nb = 2 * nt + 2;
        for (int cb = 0; cb < nb; ++cb) {
            float lr[16], li[16];
#pragma unroll
            for (int i = 0; i < 16; ++i) { lr[i] = SL[(size_t)(cb * 16 + i) * 128]; li[i] = SL[(size_t)(cb * 16 + i) * 128 + 64]; }
#pragma unroll
            for (int i = 0; i < 16; ++i) { const int c = cb * 16 + i;
                if (c >= nt * 32) { LAS unsigned short* sp = (LAS unsigned short*)(L + S5_SPL + (c - nt * 32) * S5_SPROW); sp[lane] = f2bf16(sr); sp[64 + lane] = f2bf16(si); }
                const float nr = atr * sr - ati * si + lr[i], ni = atr * si + ati * sr + li[i]; sr = nr; si = ni; }
        }
    }
    __syncthreads();
    const bf16* W2 = (const bf16*)(a.ws + WS_W2) + (size_t)g * 1024 * 128;
    const bf16* UT = (const bf16*)(a.ws + WS_UT) + ((size_t)g * NTOK + (size_t)b * SEQ + (size_t)(nt * 32 + r) * 64) * 16;
    bf16* YP = (bf16*)(a.ws + WS_YPRE) + ((size_t)b * SEQ + (size_t)(nt * 32 + r) * 64) * DS5 + g * GH;
    const LAS unsigned char* aL = L + S5_KTL + r * 32 + hf * 16;
    const LAS unsigned char* bL = L + S5_UL + r * S5_ULROW + hf * 16;
    const LAS unsigned char* sL = L + S5_SPL + r * S5_SPROW + hf * 16;
#pragma unroll 1
    for (int q = 0; q < 4; ++q) {
        const int tb = (q == 0) ? w : (q == 1) ? 15 - w : (q == 2) ? 16 + w : 31 - w;
        bf16x8 wa[8];
        { const bf16* wp = W2 + (size_t)(tb * 32 + r) * 128 + 8 * hf;
#pragma unroll
          for (int ks = 0; ks < 8; ++ks) wa[ks] = *(const bf16x8*)(wp + ks * 16); }
        f32x16 acc = zero16();
        const int nj = 2 * tb + 2;
#pragma unroll 2
        for (int j = 0; j < nj; ++j) {
            const bf16x8 av = *(const LAS bf16x8*)(aL + (2 * tb - j + 1) * 512), bv = *(const LAS bf16x8*)(bL + j * 32);
            acc = MFMA32(av, bv, acc);
        }
#pragma unroll
        for (int ks = 0; ks < 8; ++ks) { const bf16x8 bv = *(const LAS bf16x8*)(sL + ks * 32); acc = MFMA32(wa[ks], bv, acc); }
#pragma unroll
        for (int qq = 0; qq < 4; ++qq) { const int t = 2 * tb + (qq >> 1), h0 = 8 * (qq & 1) + 4 * hf;
            const unsigned long long uw = *(const unsigned long long*)(UT + (size_t)t * 16 + h0);
            const f32x4 dv = *(const f32x4*)(a.in[I_D] + g * GH + h0);
            const float u0 = __builtin_bit_cast(float, (unsigned)(uw << 16)), u1 = __builtin_bit_cast(float, (unsigned)uw & 0xffff0000u),
                        u2 = __builtin_bit_cast(float, (unsigned)(uw >> 32) << 16), u3 = __builtin_bit_cast(float, (unsigned)(uw >> 32) & 0xffff0000u);
            const float y0 = gelu_tanh(acc[4 * qq] + dv[0] * u0), y1 = gelu_tanh(acc[4 * qq + 1] + dv[1] * u1), y2 = gelu_tanh(acc[4 * qq + 2] + dv[2] * u2), y3 = gelu_tanh(acc[4 * qq + 3] + dv[3] * u3);
            *(unsigned long long*)(YP + (size_t)t * DS5 + h0) = (unsigned long long)pg8::cvt_pk_bf16(y0, y1) | ((unsigned long long)pg8::cvt_pk_bf16(y2, y3) << 32); }
    }
    __syncthreads();
}

__device__ __forceinline__ void gla_cumsum(const Frame& F, const Args& a, int h, size_t tok0, LAS float* TOT, float (&bl)[16], float& blast) {
    const int dk = F.tid & 127, tq = F.tid >> 7;
    float gu[RANK];
#pragma unroll
    for (int rr = 0; rr < RANK; ++rr) gu[rr] = a.in[I_GUP][rr * GDK + h * HK + dk];
    const float gb = a.in[I_GBIAS][h * HK + dk];
    const float* GL = (const float*)(a.ws + WS_GLOW) + (tok0 + tq * 16) * 16;
    float run = 0.f;
#pragma unroll
    for (int i = 0; i < 16; ++i) {
        const f32x4 g0 = *(const f32x4*)(GL + i * 16), g1 = *(const f32x4*)(GL + i * 16 + 4), g2 = *(const f32x4*)(GL + i * 16 + 8), g3 = *(const f32x4*)(GL + i * 16 + 12);
        float z = gb;
        z += g0[0] * gu[0]; z += g0[1] * gu[1]; z += g0[2] * gu[2]; z += g0[3] * gu[3]; z += g1[0] * gu[4]; z += g1[1] * gu[5]; z += g1[2] * gu[6]; z += g1[3] * gu[7];
        z += g2[0] * gu[8]; z += g2[1] * gu[9]; z += g2[2] * gu[10]; z += g2[3] * gu[11]; z += g3[0] * gu[12]; z += g3[1] * gu[13]; z += g3[2] * gu[14]; z += g3[3] * gu[15];
        run += log_sigmoid(z) * (1.0f / 16.0f); bl[i] = run;
    }
    TOT[tq * 128 + dk] = run;
    __syncthreads();
    const float t0 = TOT[dk], t1 = TOT[128 + dk], t2 = TOT[256 + dk], t3 = TOT[384 + dk];
    const float off = (tq > 0 ? t0 : 0.f) + (tq > 1 ? t1 : 0.f) + (tq > 2 ? t2 : 0.f);
    blast = (t0 + t1) + (t2 + t3);
#pragma unroll
    for (int i = 0; i < 16; ++i) bl[i] += off;
}
__device__ __forceinline__ void gla_stage_v(const Frame& F, const Args& a, int h, size_t tok0, LAS unsigned char* VL) {
    const bf16* V = (const bf16*)(a.ws + WS_V);
#pragma unroll
    for (int i = 0; i < 4; ++i) { const int idx = F.tid + NTHR * i, row = idx >> 5, c16 = idx & 31;
        *(LAS v4u*)(VL + row * 512 + c16 * 16) = *(const v4u*)(V + (tok0 + row) * GDV + h * HV + c16 * 8); }
}
__device__ __forceinline__ bf16x8 gla_vfrag(const LAS unsigned short* VL, int sbase, int col, bool perm) {
    unsigned short x[8];
#pragma unroll
    for (int e = 0; e < 8; ++e) { const int s = perm ? (sbase + 8 * (e >> 2) + (e & 3)) : (sbase + e); x[e] = VL[s * 256 + col]; }
    v4u p; p.x = (unsigned)x[0] | ((unsigned)x[1] << 16); p.y = (unsigned)x[2] | ((unsigned)x[3] << 16); p.z = (unsigned)x[4] | ((unsigned)x[5] << 16); p.w = (unsigned)x[6] | ((unsigned)x[7] << 16);
    return __builtin_bit_cast(bf16x8, p);
}

constexpr int GL_TOT = 0, GL_KTT = 2048, GL_KTROW = 144, GL_VL = 20480;
__device__ __forceinline__ void gla_kv_item(const Frame& F, const Args& a, int n) {
    const int bh = n >> 6, c = n & 63, b = bh >> 2, h = bh & 3, tid = F.tid, dk = tid & 127, tq = tid >> 7, w = F.wave, lane = F.lane, r = lane & 31, hf = lane >> 5;
    const size_t tok0 = (size_t)b * SEQ + (size_t)c * 64;
    LAS unsigned char* L = F.lds + RING_OFF;
    gla_stage_v(F, a, h, tok0, L + GL_VL);
    float bl[16], blast; gla_cumsum(F, a, h, tok0, (LAS float*)(L + GL_TOT), bl, blast);
    { const bf16* K = (const bf16*)(a.ws + WS_K) + (tok0 + tq * 16) * GDK + h * HK + dk; float o0[8], o1[8];
#pragma unroll
      for (int i = 0; i < 8; ++i) { o0[i] = bf2f(K[(size_t)i * GDK]) * __expf(blast - bl[i]); o1[i] = bf2f(K[(size_t)(8 + i) * GDK]) * __expf(blast - bl[8 + i]); }
      v4u p0, p1; p0.x = pg8::cvt_pk_bf16(o0[0], o0[1]); p0.y = pg8::cvt_pk_bf16(o0[2], o0[3]); p0.z = pg8::cvt_pk_bf16(o0[4], o0[5]); p0.w = pg8::cvt_pk_bf16(o0[6], o0[7]);
      p1.x = pg8::cvt_pk_bf16(o1[0], o1[1]); p1.y = pg8::cvt_pk_bf16(o1[2], o1[3]); p1.z = pg8::cvt_pk_bf16(o1[4], o1[5]); p1.w = pg8::cvt_pk_bf16(o1[6], o1[7]);
      *(LAS v4u*)(L + GL_KTT + dk * GL_KTROW + tq * 32) = p0; *(LAS v4u*)(L + GL_KTT + dk * GL_KTROW + tq * 32 + 16) = p1;
      if (tq == 0) ((float*)(a.ws + WS_DEC))[(size_t)n * HK + dk] = __expf(blast); }
    __syncthreads();
    f32x16 acc[4];
#pragma unroll
    for (int d = 0; d < 4; ++d) acc[d] = zero16();
#pragma unroll
    for (int ks = 0; ks < 4; ++ks) {
        const bf16x8 av = gla_vfrag((const LAS unsigned short*)(L + GL_VL), 16 * ks + 8 * hf, w * 32 + r, false);
#pragma unroll
        for (int d = 0; d < 4; ++d) { const bf16x8 bv = *(const LAS bf16x8*)(L + GL_KTT + (d * 32 + r) * GL_KTROW + ks * 32 + hf * 16); acc[d] = MFMA32(av, bv, acc[d]); }
    }
    bf16* KVT = (bf16*)(a.ws + WS_KVT) + ((size_t)n * HV + w * 32) * HK + r;
#pragma unroll
    for (int d = 0; d < 4; ++d)
#pragma unroll
        for (int rr = 0; rr < 16; ++rr) { const int dvl = (rr & 3) + 8 * (rr >> 2) + 4 * hf; KVT[(size_t)dvl * HK + d * 32] = f2bf16(acc[d][rr]); }
    __syncthreads();
}

__device__ __forceinline__ void gla_scan(const Args& a, int gtid, int gthreads) {
    for (int e2 = gtid; e2 < 8 * 256 * 64; e2 += gthreads) {
        const int bh = e2 >> 14, rem = e2 & 16383;
        const unsigned* KV = (const unsigned*)(a.ws + WS_KVT) + (size_t)bh * 64 * 16384 + rem;
        unsigned* SP = (unsigned*)(a.ws + WS_SPT) + (size_t)bh * 64 * 16384 + rem;
        const float* DEC = (const float*)(a.ws + WS_DEC) + (size_t)bh * 64 * HK + 2 * (rem & 63);
        float s0 = 0.f, s1 = 0.f;
#pragma unroll 1
        for (int cb = 0; cb < 8; ++cb) {
            unsigned kv[8]; float d0[8], d1[8];
#pragma unroll
            for (int i = 0; i < 8; ++i) { const int c = cb * 8 + i; kv[i] = KV[(size_t)c * 16384]; d0[i] = DEC[c * HK]; d1[i] = DEC[c * HK + 1]; }
#pragma unroll
            for (int i = 0; i < 8; ++i) { const int c = cb * 8 + i;
                SP[(size_t)c * 16384] = pg8::cvt_pk_bf16(s0, s1);
                s0 = d0[i] * s0 + __builtin_bit_cast(float, kv[i] << 16); s1 = d1[i] * s1 + __builtin_bit_cast(float, kv[i] & 0xffff0000u); }
        }
    }
}

constexpr int GO_TOT = 0, GO_QE = 2048, GO_ROW = 272, GO_KE = GO_QE + 64 * GO_ROW, GO_VL = GO_KE + 64 * GO_ROW, GO_RED = GO_VL + 32768, GO_RS = GO_RED + 2048;
__device__ __forceinline__ void gla_out_item(const Frame& F, const Args& a, int n) {
    const int bh = n >> 6, c = n & 63, b = bh >> 2, h = bh & 3, tid = F.tid, dk = tid & 127, tq = tid >> 7, w = F.wave, lane = F.lane, r = lane & 31, hf = lane >> 5;
    const size_t tok0 = (size_t)b * SEQ + (size_t)c * 64;
    LAS unsigned char* L = F.lds + RING_OFF;
    gla_stage_v(F, a, h, tok0, L + GO_VL);
    float bl[16], blast; gla_cumsum(F, a, h, tok0, (LAS float*)(L + GO_TOT), bl, blast);
    { const bf16* Q = (const bf16*)(a.ws + WS_Q) + (tok0 + tq * 16) * GDK + h * HK + dk; const bf16* K = (const bf16*)(a.ws + WS_K) + (tok0 + tq * 16) * GDK + h * HK + dk;
#pragma unroll
      for (int i = 0; i < 16; ++i) { const float e = __expf(bl[i]), ei = __expf(-bl[i]);
          *(LAS unsigned short*)(L + GO_QE + (tq * 16 + i) * GO_ROW + dk * 2) = f2bf16(bf2f(Q[(size_t)i * GDK]) * e);
          *(LAS unsigned short*)(L + GO_KE + (tq * 16 + i) * GO_ROW + dk * 2) = f2bf16(bf2f(K[(size_t)i * GDK]) * ei); } }
    __syncthreads();
    f32x16 x00 = zero16(), x01 = zero16(), x11 = zero16();
#pragma unroll
    for (int ks = 0; ks < 8; ++ks) {
        const bf16x8 ka0 = *(const LAS bf16x8*)(L + GO_KE + r * GO_ROW + ks * 32 + hf * 16), ka1 = *(const LAS bf16x8*)(L + GO_KE + (32 + r) * GO_ROW + ks * 32 + hf * 16);
        const bf16x8 qb0 = *(const LAS bf16x8*)(L + GO_QE + r * GO_ROW + ks * 32 + hf * 16), qb1 = *(const LAS bf16x8*)(L + GO_QE + (32 + r) * GO_ROW + ks * 32 + hf * 16);
        x00 = MFMA32(ka0, qb0, x00); x01 = MFMA32(ka0, qb1, x01); x11 = MFMA32(ka1, qb1, x11);
    }
#pragma unroll
    for (int rr = 0; rr < 16; ++rr) { const int sl = (rr & 3) + 8 * (rr >> 2) + 4 * hf; if (sl > r) { x00[rr] = 0.f; x11[rr] = 0.f; } }
    f32x16 ot0 = zero16(), ot1 = zero16();
    const LAS unsigned short* VL = (const LAS unsigned short*)(L + GO_VL);
#pragma unroll
    for (int kk = 0; kk < 2; ++kk) {
        const bf16x8 va0 = gla_vfrag(VL, 16 * kk + 4 * hf, w * 32 + r, true), va1 = gla_vfrag(VL, 32 + 16 * kk + 4 * hf, w * 32 + r, true);
        ot0 = MFMA32(va0, pack_step(x00, kk), ot0);
        ot1 = MFMA32(va0, pack_step(x01, kk), ot1);
        ot1 = MFMA32(va1, pack_step(x11, kk), ot1);
    }
    { const bf16* SP = (const bf16*)(a.ws + WS_SPT) + ((size_t)n * HV + w * 32 + r) * HK + 8 * hf;
#pragma unroll
      for (int ks = 0; ks < 8; ++ks) { const bf16x8 sa = *(const bf16x8*)(SP + ks * 16);
          const bf16x8 qb0 = *(const LAS bf16x8*)(L + GO_QE + r * GO_ROW + ks * 32 + hf * 16), qb1 = *(const LAS bf16x8*)(L + GO_QE + (32 + r) * GO_ROW + ks * 32 + hf * 16);
          ot0 = MFMA32(sa, qb0, ot0); ot1 = MFMA32(sa, qb1, ot1); } }
    { float s0 = 0.f, s1 = 0.f;
#pragma unroll
      for (int rr = 0; rr < 16; ++rr) { s0 += ot0[rr] * ot0[rr]; s1 += ot1[rr] * ot1[rr]; }
      s0 += __shfl_xor(s0, 32); s1 += __shfl_xor(s1, 32);
      LAS float* RED = (LAS float*)(L + GO_RED);
      if (hf == 0) { RED[w * 64 + r] = s0; RED[w * 64 + 32 + r] = s1; } }
    __syncthreads();
    if (tid < 64) { const LAS float* RED = (const LAS float*)(L + GO_RED); float t = 0.f;
#pragma unroll
        for (int ww = 0; ww < 8; ++ww) t += RED[ww * 64 + tid];
        ((LAS float*)(L + GO_RS))[tid] = 1.0f / sqrtf(t * (1.0f / HV) + EPS); }
    __syncthreads();
    { const LAS float* RS = (const LAS float*)(L + GO_RS); const float rs0 = RS[r], rs1 = RS[32 + r];
      const bf16* ZG = (const bf16*)(a.ws + WS_ZGLA); bf16* CC = (bf16*)(a.ws + WS_CONCAT);
#pragma unroll
      for (int bb = 0; bb < 2; ++bb) { const size_t tok = tok0 + bb * 32 + r; const float rs = bb ? rs1 : rs0;
#pragma unroll
          for (int qq = 0; qq < 4; ++qq) { const int dv = w * 32 + 8 * qq + 4 * hf;
              const f32x4 nw = *(const f32x4*)(a.in[I_GNORM] + dv);
              const unsigned long long zw = *(const unsigned long long*)(ZG + tok * GDV + h * HV + dv);
              const float z0 = __builtin_bit_cast(float, (unsigned)(zw << 16)), z1 = __builtin_bit_cast(float, (unsigned)zw & 0xffff0000u),
                          z2 = __builtin_bit_cast(float, (unsigned)(zw >> 32) << 16), z3 = __builtin_bit_cast(float, (unsigned)(zw >> 32) & 0xffff0000u);
              const f32x16& o = bb ? ot1 : ot0;
              const float y0 = o[4 * qq] * rs * nw[0] * z0, y1 = o[4 * qq + 1] * rs * nw[1] * z1, y2 = o[4 * qq + 2] * rs * nw[2] * z2, y3 = o[4 * qq + 3] * rs * nw[3] * z3;
              *(unsigned long long*)(CC + tok * 2048 + 1024 + h * HV + dv) = (unsigned long long)pg8::cvt_pk_bf16(y0, y1) | ((unsigned long long)pg8::cvt_pk_bf16(y2, y3) << 32); } } }
    __syncthreads();
}

constexpr int NPHASE = 7;
__global__ void __launch_bounds__(NTHR, 2) mega_fwd(Args a) {
    extern __shared__ __attribute__((aligned(16))) unsigned char lds[];
    Frame F;
    F.lds = (LAS unsigned char*)lds; F.MISC = (volatile LAS unsigned*)(F.lds + MISC_OFF);
    F.tid = threadIdx.x; F.lane = F.tid & 63; F.wave = __builtin_amdgcn_readfirstlane(F.tid >> 6);
    F.G = gridDim.x; { const int bx = blockIdx.x; F.vcu = (F.G % 8 == 0) ? (bx % 8) * (F.G / 8) + bx / 8 : bx; }
    F.ctl = (gu32*)(a.ws + WS_CTL);
    for (int u = F.tid; u < (LDS_BYTES - LDSCTL_OFF) / 4; u += NTHR) ((LAS unsigned*)(F.lds + LDSCTL_OFF))[u] = 0u;
    __syncthreads();
    const int lo = a.ph_lo, hi = a.ph_hi;
    const bool use_bar = (hi - lo) > 1;
    XcdBarrier bar; bar.bar = (unsigned*)(F.ctl + CW_BAR); bar.x = 0; bar.st = nullptr;
    if (use_bar) bar = xcd_barrier_post((unsigned*)(F.ctl + CW_BAR), F.MISC + 8);
#define IN(k) (lo <= (k) && (k) < hi)
#define SEAM(k) do { if (IN(k) && IN((k) + 1)) xcd_barrier(bar); } while (0)
    const int gtid = blockIdx.x * NTHR + F.tid, gthreads = F.G * NTHR;
    const int gw = blockIdx.x * NWAVES + F.wave, NGW = F.G * NWAVES;
    unsigned char* ws = a.ws;

    if (IN(0)) {
#if FAST_S5
        for (int it = (int)blockIdx.x; it < 256; it += F.G) s5_tables(F, a, it >> 2, it & 3);
#endif
        p0_prologue(F, a);
    }
    SEAM(0);

    if (IN(1)) {
        ProjSink ps{(bf16*)(ws + WS_UT), (bf16*)(ws + WS_ZS5), (bf16*)(ws + WS_Q), (bf16*)(ws + WS_K), (bf16*)(ws + WS_V), (bf16*)(ws + WS_ZGLA), (float*)(ws + WS_GLOW)};
#if FAST_GEMM
        pg8::Gemm g{(const pg8::bf16_t*)(ws + WS_XN), (const pg8::bf16_t*)(ws + WS_WIN), NTOK, DINP, DM}; pg8::StaticOrder S; S.init(NTOK, DINP, F.G, (int)blockIdx.x);
        pg8::Epi8<ProjSink> E{ps};
        pg8::gemm_phase<pg8::Epi8<ProjSink>, pg8::StaticOrder, PG8_ALIGN, PG8_SP2>(F.lds + RING_OFF, g, S, E);
#else
        naive_gemm((const bf16*)(ws + WS_XN), (const bf16*)(ws + WS_WIN), NTOK, DINP, DM, ps, gtid, gthreads);
#endif
    }
    SEAM(1);

    if (IN(2)) {
#if FAST_GLA
        for (int n = (int)blockIdx.x; n < 512; n += F.G) gla_kv_item(F, a, n);
#endif
#if FAST_S5
        for (int it = (int)blockIdx.x; it < 128; it += F.G) s5_sloc_item(F, a, it);
#endif
    }
    SEAM(2);

    if (IN(3)) {
#if FAST_S5
        for (int it = (int)blockIdx.x; it < 256; it += F.G) s5_main_item(F, a, it);
#else
        if (blockIdx.x >= 8 && blockIdx.x < 8 + 16) s5_naive_item(a, ((int)blockIdx.x - 8) * NWAVES + F.wave, F.lane);
#endif
#if FAST_GLA
        gla_scan(a, gtid, gthreads);
#else
        if (blockIdx.x < 8) gla_naive_item(F, a, (int)blockIdx.x);
#endif
    }
    SEAM(3);

    if (IN(4)) {
        GluSink gs{(const bf16*)(ws + WS_YPRE), (const bf16*)(ws + WS_ZS5), a.in[I_GLUB], (bf16*)(ws + WS_CONCAT)};
#if FAST_GEMM
        pg8::Gemm g{(const pg8::bf16_t*)(ws + WS_YPRE), (const pg8::bf16_t*)(ws + WS_WGLU), NTOK, DS5, DS5}; pg8::StaticOrder S; S.init(NTOK, DS5, F.G, (int)blockIdx.x);
        pg8::Epi8<GluSink> E{gs};
        pg8::gemm_phase<pg8::Epi8<GluSink>, pg8::StaticOrder, PG8_ALIGN, PG8_SP2>(F.lds + RING_OFF, g, S, E);
#else
        naive_gemm((const bf16*)(ws + WS_YPRE), (const bf16*)(ws + WS_WGLU), NTOK, DS5, DS5, gs, gtid, gthreads);
#endif
#if FAST_GLA
        __syncthreads();
        for (int n = (int)blockIdx.x; n < 512; n += F.G) gla_out_item(F, a, n);
#endif
    }
    SEAM(4);

    if (IN(5)) {
        MixSink ms{(bf16*)(ws + WS_MIXED)};
#if FAST_GEMM
        pg8::Gemm g{(const pg8::bf16_t*)(ws + WS_CONCAT), (const pg8::bf16_t*)(ws + WS_WOUT), NTOK, DM, DM}; pg8::StaticOrder S; S.init(NTOK, DM, F.G, (int)blockIdx.x);
        pg8::Epi8<MixSink> E{ms};
        pg8::gemm_phase<pg8::Epi8<MixSink>, pg8::StaticOrder, PG8_ALIGN, PG8_SP2>(F.lds + RING_OFF, g, S, E);
#else
        naive_gemm((const bf16*)(ws + WS_CONCAT), (const bf16*)(ws + WS_WOUT), NTOK, DM, DM, ms, gtid, gthreads);
#endif
    }
    SEAM(5);

    if (IN(6)) {
        for (int m = gw; m < NTOK; m += NGW) p6_row(a.in[I_X] + (size_t)m * DM, (const bf16*)(ws + WS_MIXED) + (size_t)m * DM, a.in[I_POSTW], a.out + (size_t)m * DM, F.lane);
    }
#undef IN
#undef SEAM
}

extern "C" void kernel_launch(void* const* d_in, const int* in_sizes, int n_in, void* d_out, int out_size, void* d_ws, size_t ws_size, hipStream_t stream) {
    static int grid = 0;
    if (grid == 0) {
        if (n_in != N_IN || out_size != NTOK * DM || ws_size < WS_END) { fprintf(stderr, "kernel_launch: unexpected problem shape (n_in %d out %d ws %zu)\n", n_in, out_size, ws_size); grid = -1; return; }
        int dev = 0, cus = 0;
        if (hipGetDevice(&dev) != hipSuccess || hipDeviceGetAttribute(&cus, hipDeviceAttributeMultiprocessorCount, dev) != hipSuccess) { grid = -1; return; }
        if (hipFuncSetAttribute((const void*)mega_fwd, hipFuncAttributeMaxDynamicSharedMemorySize, LDS_BYTES) != hipSuccess) { fprintf(stderr, "kernel_launch: hipFuncSetAttribute failed\n"); grid = -1; return; }
        grid = cus;
    }
    if (grid < 0) return;
    (void)hipMemsetAsync((char*)d_ws + WS_CTL, 0, CTL_ZERO_BYTES, stream);
    Args a{};
    for (int i = 0; i < N_IN; ++i) a.in[i] = (const float*)d_in[i];
    a.out = (float*)d_out; a.ws = (unsigned char*)d_ws;
#if MK_ONE_LAUNCH
    a.ph_lo = 0; a.ph_hi = NPHASE;
    hipLaunchKernelGGL(mega_fwd, dim3(grid), dim3(NTHR), LDS_BYTES, stream, a);
#else
    for (int p = 0; p < NPHASE; ++p) {
        if (p == 2 && !(FAST_S5 || FAST_GLA)) continue;
        a.ph_lo = p; a.ph_hi = p + 1;
        hipLaunchKernelGGL(mega_fwd, dim3(grid), dim3(NTHR), LDS_BYTES, stream, a);
    }
#endif
}
```

```cpp
#include <hip/hip_runtime.h>
#include <cstdio>
#include <cstdint>

#define MK_ONE_LAUNCH 1
#define FAST_GEMM 1
#define FAST_S5 1
#define FAST_GLA 1
#define DUP_PHASE -1
#define REP_PHASE -1

namespace pg8 {
#define PG8_LAS __attribute__((address_space(3)))
typedef unsigned short bf16_t;
typedef short bf16x8 __attribute__((ext_vector_type(8)));
typedef float f32x4 __attribute__((ext_vector_type(4)));
typedef unsigned u32x4 __attribute__((ext_vector_type(4)));
constexpr int BM = 256, BK = 64, HALF = 128, HTB = HALF * BK * 2  , STAGE_BYTES = 8 * HTB, NXCD = 8, WGM = 8;

__host__ __device__ __forceinline__ int lds_byte(int r, int c) { const int st = (r >> 4) * 2 + (c >> 5), rr = r & 15, cc = c & 31, ob = rr * 64 + cc * 2; return st * 1024 + (ob ^ (((ob >> 9) & 1) << 5)); }
__host__ __device__ __forceinline__ void stage_rc(int b, int& R, int& C) { const int st = b / 1024, sb = b % 1024, swz = sb ^ (((sb >> 9) & 1) << 5); R = (st >> 1) * 16 + swz / 64; C = (st & 1) * 32 + (swz % 64) / 2; }
__host__ __device__ __forceinline__ int perm32(int rho) { const int n = rho >> 4, i = rho & 15; return 8 * (i >> 2) + 4 * n + (i & 3); }

struct Unit { int pm, pn; };
struct Gemm { const bf16_t* A; const bf16_t* Bt; int M, N, K; };

struct StaticOrder {
    int nM, nN, nwg, G, c;
    __host__ __device__ void init(int M, int N, int G_, int c_) { nM = M / BM; nN = N / BM; nwg = nM * nN; G = G_; c = c_; }
    __host__ __device__ bool next(int i, Unit& u) const {
        const long L = (long)i * G + c; if (L >= nwg) return false;
        int wgid = (int)L; { const int q = nwg / NXCD, r = nwg % NXCD, xcd = wgid % NXCD, off = wgid / NXCD; wgid = (xcd < r ? xcd * (q + 1) : r * (q + 1) + (xcd - r) * q) + off; }
        const int nig = WGM * nN, gid = wgid / nig, fm = gid * WGM, gsz = (nM - fm) < WGM ? (nM - fm) : WGM;
        u.pm = fm + ((wgid % nig) % gsz); u.pn = (wgid % nig) / gsz; return true;
    }
    __device__ __forceinline__ void a_ready(const Unit&) const {}
    __device__ __forceinline__ void done(const Unit&) const {}
};

__device__ __forceinline__ unsigned cvt_pk_bf16(float lo, float hi) { unsigned r; asm volatile("v_cvt_pk_bf16_f32 %0, %1, %2" : "=v"(r) : "v"(lo), "v"(hi)); return r; }
typedef float f32x2 __attribute__((ext_vector_type(2)));
__device__ __forceinline__ f32x2 gelu_pk(f32x2 v) {
    const f32x2 av = __builtin_elementwise_abs(v), d = av * 0.2316418882f + 1.0f;
    f32x2 t; t.x = __builtin_amdgcn_rcpf(d.x); t.y = __builtin_amdgcn_rcpf(d.y);
    f32x2 q = t * 0.5307027145f + (-0.7265760135f); q = q * t + 0.7107068705f; q = q * t + (-0.142248368f); q = q * t + 0.127414796f; q = q * t;
    const f32x2 s = (v * v) * (-0.72134752044f);
    f32x2 e; e.x = __builtin_amdgcn_exp2f(s.x); e.y = __builtin_amdgcn_exp2f(s.y);
    const f32x2 m = v * (q * e), r = v - m;
    f32x2 o; o.x = v.x < 0.f ? m.x : r.x; o.y = v.y < 0.f ? m.y : r.y; return o;
}

template <int ACT  > struct EpiBf16 {
    static constexpr bool PERM = true, AFTER_DRAIN = false; static_assert(ACT == 0 || ACT == 1, "EpiBf16: ACT is 0 (none) or 1 (gelu_pk)");
    bf16_t* O; int ldc; const float* bias; int split_cols; size_t split_stride; float scale0;
    __device__ __forceinline__ void operator()(const f32x4 (&acc)[2][2][4][2], const Unit& u, int wr, int wc, int fr, int fq) const {
        const int row0 = u.pm * BM + wr * 64 + fr; int colt = u.pn * BM; bf16_t* base = O;
        float sc = 1.f; if (split_cols) { const int t = colt / split_cols; base += (size_t)t * split_stride; colt -= t * split_cols; if (t == 0) sc = scale0; }
        const int col0 = colt + wc * 32 + 8 * fq, bcol0 = u.pn * BM + wc * 32 + 8 * fq;
        f32x4 bv[2][2];
#pragma unroll
        for (int bj = 0; bj < 2; ++bj)
#pragma unroll
            for (int n = 0; n < 2; ++n) bv[bj][n] = bias ? *(const f32x4*)(bias + bcol0 + bj * HALF + 4 * n) : (f32x4){0.f, 0.f, 0.f, 0.f};
#pragma unroll
        for (int ai = 0; ai < 2; ++ai)
#pragma unroll
            for (int m = 0; m < 4; ++m) { bf16_t* rowp = base + (size_t)(row0 + ai * HALF + m * 16) * ldc + col0;
#pragma unroll
                for (int bj = 0; bj < 2; ++bj) { f32x4 v0 = acc[ai][bj][m][0] + bv[bj][0], v1 = acc[ai][bj][m][1] + bv[bj][1];
                    if (ACT == 1) { f32x2 a = gelu_pk((f32x2){v0[0], v0[1]}), b = gelu_pk((f32x2){v0[2], v0[3]}), c = gelu_pk((f32x2){v1[0], v1[1]}), d = gelu_pk((f32x2){v1[2], v1[3]});
                        v0 = (f32x4){a.x, a.y, b.x, b.y}; v1 = (f32x4){c.x, c.y, d.x, d.y}; }
                    v0 = v0 * sc; v1 = v1 * sc; u32x4 w; w.x = cvt_pk_bf16(v0[0], v0[1]); w.y = cvt_pk_bf16(v0[2], v0[3]); w.z = cvt_pk_bf16(v1[0], v1[1]); w.w = cvt_pk_bf16(v1[2], v1[3]);
                    *(u32x4*)(rowp + bj * HALF) = w; } }
    }
};

template <class Sink> struct Epi8 {
    static constexpr bool PERM = true, AFTER_DRAIN = false;
    Sink s;
    __device__ __forceinline__ void operator()(const f32x4 (&acc)[2][2][4][2], const Unit& u, int wr, int wc, int fr, int fq) const {
        const int row0 = u.pm * BM + wr * 64 + fr, col0 = u.pn * BM + wc * 32 + 8 * fq;
#pragma unroll
        for (int ai = 0; ai < 2; ++ai)
#pragma unroll
            for (int m = 0; m < 4; ++m)
#pragma unroll
                for (int bj = 0; bj < 2; ++bj) {
                    const f32x4 a0 = acc[ai][bj][m][0], a1 = acc[ai][bj][m][1];
                    const float v[8] = {a0[0], a0[1], a0[2], a0[3], a1[0], a1[1], a1[2], a1[3]};
                    s(row0 + ai * HALF + m * 16, col0 + bj * HALF, v);
                }
    }
};

template <class Epi, class Sched, bool ALIGN_EPI = false, bool SP2 = false>
__device__ __forceinline__ void gemm_phase(PG8_LAS unsigned char* lds, const Gemm g, const Sched& S, const Epi& E) {
    const int tid = threadIdx.x, wid = __builtin_amdgcn_readfirstlane(tid >> 6), lane = tid & 63, wr = wid >> 2, wc = wid & 3, fr = lane & 15, fq = lane >> 4;
    const int K = g.K, nt = K / BK;
    unsigned voffA[2], voffB[2];
#pragma unroll
    for (int i = 0; i < 2; ++i) { int R, C; stage_rc(tid * 16 + i * 8192, R, C); const int Rb = Epi::PERM ? ((R & ~31) + perm32(R & 31)) : R;
        voffA[i] = (unsigned)(R * K + C) * 2u; voffB[i] = (unsigned)(Rb * K + C) * 2u; }
    const size_t kstep = (size_t)(BK * 2);
    const size_t hstep = (size_t)HALF * K * 2;
    const size_t tstep = 2 * hstep;
    const unsigned ldsw = (unsigned)wid * 1024u;
    const int aoff = lds_byte(wr * 64 + fr, fq * 8), boff = lds_byte(wc * 32 + fr, fq * 8);
#define PG8_SA(b, h) (((b) * 2 + (h)) * HTB)
#define PG8_SB(b, h) ((4 + (b) * 2 + (h)) * HTB)
#define PG8_STAGE(bufoff, gbase, voff) do { _Pragma("unroll") for (int _i = 0; _i < 2; ++_i) \
        __builtin_amdgcn_global_load_lds((const unsigned*)((const char*)(gbase) + (voff)[_i]), (PG8_LAS unsigned*)(lds + (bufoff) + ldsw + _i * 8192), 16, 0, 0); } while (0)
#define PG8_LDA(dst, b, h) do { _Pragma("unroll") for (int m = 0; m < 4; ++m) _Pragma("unroll") for (int k = 0; k < 2; ++k) dst[m][k] = *(const PG8_LAS bf16x8*)(lds + PG8_SA(b, h) + aoff + m * 2048 + k * 1024); } while (0)
#define PG8_LDB(dst, b, h) do { _Pragma("unroll") for (int n = 0; n < 2; ++n) _Pragma("unroll") for (int k = 0; k < 2; ++k) dst[n][k] = *(const PG8_LAS bf16x8*)(lds + PG8_SB(b, h) + boff + n * 2048 + k * 1024); } while (0)
#define PG8_MMA(ai, bj, At, Bt) do { __builtin_amdgcn_s_setprio(1); _Pragma("unroll") for (int m = 0; m < 4; ++m) _Pragma("unroll") for (int n = 0; n < 2; ++n) _Pragma("unroll") for (int k = 0; k < 2; ++k) \
        acc[ai][bj][m][n] = __builtin_amdgcn_mfma_f32_16x16x32_bf16(Bt[n][k], At[m][k], acc[ai][bj][m][n], 0, 0, 0); __builtin_amdgcn_s_setprio(0); } while (0)
#define PG8_WAIT_V(n) asm volatile("s_waitcnt vmcnt(" #n ")" ::: "memory")
#define PG8_WAIT_L(n) asm volatile("s_waitcnt lgkmcnt(" #n ")" ::: "memory")
#define PG8_BAR __builtin_amdgcn_s_barrier()
#define PG8_SCHED __builtin_amdgcn_sched_barrier(0)
    Unit cur, nxt; int ui = 0;
    if (!S.next(0, cur)) return;
    f32x4 acc[2][2][4][2];
#pragma unroll
    for (int a = 0; a < 2; ++a)
#pragma unroll
        for (int b = 0; b < 2; ++b)
#pragma unroll
            for (int m = 0; m < 4; ++m)
#pragma unroll
                for (int n = 0; n < 2; ++n) acc[a][b][m][n] = (f32x4){0.f, 0.f, 0.f, 0.f};
    bf16x8 At[4][2], B0[2][2], B1[2][2];
    const char* cA = (const char*)g.A + (size_t)cur.pm * tstep; const char* cB = (const char*)g.Bt + (size_t)cur.pn * tstep;
    S.a_ready(cur);
    if constexpr (SP2) {
        PG8_STAGE(PG8_SB(0, 0), cB, voffB); PG8_STAGE(PG8_SB(0, 1), cB + hstep, voffB); PG8_STAGE(PG8_SA(0, 0), cA, voffA); PG8_STAGE(PG8_SA(0, 1), cA + hstep, voffA);
        if (wr == 1) PG8_BAR;
        PG8_WAIT_V(2); PG8_BAR;
        PG8_STAGE(PG8_SB(1, 0), cB + kstep, voffB); PG8_STAGE(PG8_SA(1, 0), cA + kstep, voffA); PG8_STAGE(PG8_SB(1, 1), cB + hstep + kstep, voffB);
        PG8_WAIT_V(6); PG8_BAR;
    } else {
        PG8_STAGE(PG8_SB(0, 0), cB, voffB); PG8_STAGE(PG8_SA(0, 0), cA, voffA); PG8_STAGE(PG8_SB(0, 1), cB + hstep, voffB); PG8_STAGE(PG8_SA(0, 1), cA + hstep, voffA);
        if (wr == 1) PG8_BAR;
        PG8_WAIT_V(4); PG8_BAR;
        PG8_STAGE(PG8_SB(1, 0), cB + kstep, voffB); PG8_STAGE(PG8_SA(1, 0), cA + kstep, voffA); PG8_STAGE(PG8_SB(1, 1), cB + hstep + kstep, voffB);
        PG8_WAIT_V(6); PG8_BAR;
    }
    for (;;) {
        const bool has_next = S.next(ui + 1, nxt);
        const char* nA = has_next ? (const char*)g.A + (size_t)nxt.pm * tstep : cA; const char* nB = has_next ? (const char*)g.Bt + (size_t)nxt.pn * tstep : cB;
        for (int t = 0; t < nt; t += 2) {
            const bool last = (t == nt - 2);
            const char* a1 = cA + (size_t)(t + 1) * kstep;
            const char* a2 = last ? nA : cA + (size_t)(t + 2) * kstep; const char* b2 = last ? nB : cB + (size_t)(t + 2) * kstep;
            const char* a3 = a2 + kstep; const char* b3 = b2 + kstep;
            if (last && has_next) S.a_ready(nxt);
            if constexpr (SP2) {
            PG8_LDB(B0, 0, 0); PG8_LDB(B1, 0, 1); PG8_SCHED; PG8_LDA(At, 0, 0); PG8_STAGE(PG8_SA(1, 1), a1 + hstep, voffA);
            PG8_WAIT_V(8); PG8_WAIT_L(0); PG8_BAR; PG8_MMA(0, 0, At, B0); PG8_MMA(0, 1, At, B1); PG8_BAR; PG8_SCHED;
            PG8_LDA(At, 0, 1); PG8_STAGE(PG8_SB(0, 0), b2, voffB); PG8_STAGE(PG8_SB(0, 1), b2 + hstep, voffB); PG8_STAGE(PG8_SA(0, 0), a2, voffA);
            PG8_WAIT_V(8); PG8_WAIT_L(0); PG8_BAR; PG8_MMA(1, 0, At, B0); PG8_MMA(1, 1, At, B1); PG8_BAR; PG8_SCHED;
            PG8_LDB(B0, 1, 0); PG8_LDB(B1, 1, 1); PG8_SCHED; PG8_LDA(At, 1, 0); PG8_STAGE(PG8_SA(0, 1), a2 + hstep, voffA);
            PG8_WAIT_V(8); PG8_WAIT_L(0); PG8_BAR; PG8_MMA(0, 0, At, B0); PG8_MMA(0, 1, At, B1); PG8_BAR; PG8_SCHED;
            PG8_LDA(At, 1, 1); PG8_STAGE(PG8_SB(1, 0), b3, voffB); PG8_STAGE(PG8_SB(1, 1), b3 + hstep, voffB); PG8_STAGE(PG8_SA(1, 0), a3, voffA);
            PG8_WAIT_V(8); PG8_WAIT_L(0); PG8_BAR; PG8_MMA(1, 0, At, B0); PG8_MMA(1, 1, At, B1); PG8_BAR; PG8_SCHED;
            } else {
            PG8_LDB(B0, 0, 0); PG8_SCHED; PG8_LDA(At, 0, 0); PG8_STAGE(PG8_SA(1, 1), a1 + hstep, voffA);
            PG8_WAIT_L(8); PG8_BAR; PG8_WAIT_L(0); PG8_MMA(0, 0, At, B0); PG8_BAR; PG8_SCHED;
            PG8_LDB(B1, 0, 1); PG8_STAGE(PG8_SB(0, 0), b2, voffB);
            PG8_BAR; PG8_WAIT_L(0); PG8_MMA(0, 1, At, B1); PG8_BAR;
            PG8_LDA(At, 0, 1); PG8_STAGE(PG8_SA(0, 0), a2, voffA);
            PG8_BAR; PG8_WAIT_L(0); PG8_MMA(1, 0, At, B0); PG8_BAR; PG8_SCHED;
            PG8_STAGE(PG8_SB(0, 1), b2 + hstep, voffB);
            PG8_WAIT_V(6); PG8_BAR; PG8_MMA(1, 1, At, B1); PG8_BAR;
            PG8_LDB(B0, 1, 0); PG8_SCHED; PG8_LDA(At, 1, 0); PG8_STAGE(PG8_SA(0, 1), a2 + hstep, voffA);
            PG8_WAIT_L(8); PG8_BAR; PG8_WAIT_L(0); PG8_MMA(0, 0, At, B0); PG8_BAR; PG8_SCHED;
            PG8_LDB(B1, 1, 1); PG8_STAGE(PG8_SB(1, 0), b3, voffB);
            PG8_BAR; PG8_WAIT_L(0); PG8_MMA(0, 1, At, B1); PG8_BAR;
            PG8_LDA(At, 1, 1); PG8_STAGE(PG8_SA(1, 0), a3, voffA);
            PG8_BAR; PG8_WAIT_L(0); PG8_MMA(1, 0, At, B0); PG8_BAR; PG8_SCHED;
            PG8_STAGE(PG8_SB(1, 1), b3 + hstep, voffB);
            PG8_WAIT_V(6); PG8_BAR; PG8_MMA(1, 1, At, B1); PG8_BAR;
            }
        }
        if constexpr (ALIGN_EPI) { if (wr == 0) PG8_BAR; }
        if constexpr (!Epi::AFTER_DRAIN) { E(acc, cur, wr, wc, fr, fq); S.done(cur); }
        if (!has_next) break;
#pragma unroll
        for (int a = 0; a < 2; ++a)
#pragma unroll
            for (int b = 0; b < 2; ++b)
#pragma unroll
                for (int m = 0; m < 4; ++m)
#pragma unroll
                    for (int n = 0; n < 2; ++n) acc[a][b][m][n] = (f32x4){0.f, 0.f, 0.f, 0.f};
        cur = nxt; cA = nA; cB = nB; ++ui;
        if constexpr (ALIGN_EPI) { if (wr == 1) PG8_BAR; }
    }
    PG8_WAIT_V(0);
    if constexpr (!ALIGN_EPI) { if (wr == 0) PG8_BAR; }
    PG8_BAR;
    if constexpr (Epi::AFTER_DRAIN) { E.fused(acc, cur, wr, wc, fr, fq, lds, wid, lane); S.done(cur); }
#undef PG8_SA
#undef PG8_SB
#undef PG8_STAGE
#undef PG8_LDA
#undef PG8_LDB
#undef PG8_MMA
#undef PG8_WAIT_V
#undef PG8_WAIT_L
#undef PG8_BAR
#undef PG8_SCHED
}
}

#ifndef PG8_SP2
#define PG8_SP2 true
#endif
#ifndef PG8_ALIGN
#define PG8_ALIGN true
#endif

#define GAS __attribute__((address_space(1)))
#define LAS __attribute__((address_space(3)))
typedef unsigned short bf16;
typedef unsigned v4u __attribute__((ext_vector_type(4)));
typedef float f32x4 __attribute__((ext_vector_type(4)));
typedef short bf16x8 __attribute__((ext_vector_type(8)));
typedef GAS unsigned gu32;
typedef GAS unsigned long long gu64;
#define RLX_AGENT __ATOMIC_RELAXED, __HIP_MEMORY_SCOPE_AGENT
#define LDS_WAIT() asm volatile("s_waitcnt lgkmcnt(0)" ::: "memory")
#define VM_WAIT() asm volatile("s_waitcnt vmcnt(0)" ::: "memory")
__device__ __forceinline__ unsigned long long rt() { return __builtin_amdgcn_s_memrealtime(); }
__device__ __forceinline__ unsigned f2bf(float f) { unsigned u = __builtin_bit_cast(unsigned, f); return (u + 0x7fffu + ((u >> 16) & 1u)) >> 16; }
__device__ __forceinline__ unsigned pk2(float lo, float hi) { return f2bf(lo) | (f2bf(hi) << 16); }

#define XB_TMO      128
#define XB_XCNT(j)  (256  + 64 * (j))
#define XB_XSUB(j)  (1280 + 64 * (j))
#define XB_XGEN(j)  (2304 + 64 * (j))
#define XB_TOP      3328
#define XB_TOPGEN   3392
#define XCD_BAR_WORDS 3456
#define XB_SPIN_CAP (1u << 18)

__device__ __forceinline__ unsigned xb_ld(unsigned* p)              { return __hip_atomic_load(p, __ATOMIC_RELAXED, __HIP_MEMORY_SCOPE_AGENT); }
__device__ __forceinline__ unsigned xb_add(unsigned* p, unsigned v) { return __hip_atomic_fetch_add(p, v, __ATOMIC_RELAXED, __HIP_MEMORY_SCOPE_AGENT); }
__device__ __forceinline__ unsigned xb_xcc_id() { return (unsigned)__builtin_amdgcn_s_getreg((3 << 11) | 20) & 0xFu; }
#define XB_SPIN(cond, bar) do { unsigned _sp = 0; while (cond) { __builtin_amdgcn_s_sleep(1); \
    if ((++_sp & 255u) == 0u) { if (xb_ld(&(bar)[XB_TMO])) break; if (_sp > XB_SPIN_CAP) { atomicAdd(&(bar)[XB_TMO], 1u); break; } } } } while (0)

struct XcdBarrier {
    unsigned* bar; unsigned x;
    volatile LAS unsigned* st;
};

__device__ __forceinline__ XcdBarrier xcd_barrier_post(unsigned* bar, volatile LAS unsigned* st) {
    XcdBarrier b; b.bar = bar; b.x = xb_xcc_id(); b.st = st;
    if (threadIdx.x == 0) (void)xb_add(&bar[XB_XCNT(b.x)], 1u);
    return b;
}
__device__ __forceinline__ void xcd_barrier_complete(unsigned* bar, unsigned x, unsigned& nloc, unsigned& nx) {
    const unsigned G = gridDim.x * gridDim.y * gridDim.z;
    unsigned sum, cnt, mine, sp = 0u;
    for (;;) {
        sum = 0u; cnt = 0u; mine = 0u;
#pragma unroll
        for (unsigned j = 0; j < 16; ++j) { const unsigned c = xb_ld(&bar[XB_XCNT(j)]); sum += c; cnt += (c > 0u) ? 1u : 0u; mine = (j == x) ? c : mine; }
        if (sum == G) break;
        __builtin_amdgcn_s_sleep(1);
        if ((++sp & 255u) == 0u) { if (xb_ld(&bar[XB_TMO])) break; if (sp > XB_SPIN_CAP) { atomicAdd(&bar[XB_TMO], 1u); break; } }
    }
    nloc = mine > 0u ? mine : 1u; nx = cnt > 0u ? cnt : 1u;
}

__device__ __forceinline__ void xcd_barrier(const XcdBarrier& b) {
    asm volatile("s_waitcnt vmcnt(0)" ::: "memory");
    __syncthreads();
    if (threadIdx.x == 0) {
        unsigned* bar = b.bar;
        __builtin_amdgcn_s_waitcnt(0);
        unsigned nloc = b.st[0], nx = b.st[1];
        if (nloc == 0u) { xcd_barrier_complete(bar, b.x, nloc, nx); b.st[0] = nloc; b.st[1] = nx; }
        const unsigned old = xb_add(&bar[XB_XSUB(b.x)], 1u);
        const unsigned gen = old / nloc;
        if (old + 1u == (gen + 1u) * nloc) {
            __builtin_amdgcn_fence(__ATOMIC_RELEASE, "agent");
            asm volatile("s_waitcnt vmcnt(0)" ::: "memory");
            const unsigned og = xb_add(&bar[XB_TOP], 1u);
            const unsigned tg = og / nx;
            if (og + 1u == (tg + 1u) * nx) xb_add(&bar[XB_TOPGEN], 1u);
            else XB_SPIN(xb_ld(&bar[XB_TOPGEN]) == tg, bar);
            __builtin_amdgcn_fence(__ATOMIC_ACQUIRE, "agent");
            xb_add(&bar[XB_XGEN(b.x)], 1u);
            asm volatile("s_waitcnt vmcnt(0)" ::: "memory");
        } else {
            XB_SPIN(xb_ld(&bar[XB_XGEN(b.x)]) == gen, bar);
            __builtin_amdgcn_fence(__ATOMIC_ACQUIRE, "agent");
            asm volatile("s_waitcnt vmcnt(0)" ::: "memory");
        }
    }
    __syncthreads();
}

constexpr int NWAVES = 8, NTHR = 512;
constexpr int DM = 2048, NTOK = 8192, SEQ = 4096;
constexpr int DS5 = 1024, NGRP = 64, GH = 16, NST = 64;
constexpr int NHEAD = 4, GDK = 512, GDV = 1024, HK = 128, HV = 256, RANK = 16, CHUNK = 64, NCHUNK = 64;
constexpr int DIN = 5136, DINP = 5376;
constexpr float EPS = 1e-6f;
enum { I_X = 0, I_PREW, I_WIN, I_ARE, I_AIM, I_BRE, I_BIM, I_CRE, I_CIM, I_D, I_LOGDT, I_GLUW, I_GLUB, I_GUP, I_GBIAS, I_GNORM, I_WOUT, I_POSTW, N_IN };

constexpr size_t MiB = 1u << 20;
constexpr size_t WS_CTL = 0, CTL_ZERO_BYTES = 65536;
constexpr size_t WS_WIN = 1 * MiB;
constexpr size_t WS_WGLU = 22 * MiB;
constexpr size_t WS_WOUT = 24 * MiB;
constexpr size_t WS_XN = 32 * MiB;
constexpr size_t WS_KVT = 32 * MiB;
constexpr size_t WS_CONCAT = 32 * MiB;
constexpr size_t WS_UT = 64 * MiB;
constexpr size_t WS_ZS5 = 80 * MiB;
constexpr size_t WS_MIXED = 64 * MiB;
constexpr size_t WS_Q = 96 * MiB;
constexpr size_t WS_K = 104 * MiB;
constexpr size_t WS_V = 112 * MiB;
constexpr size_t WS_ZGLA = 128 * MiB;
constexpr size_t WS_GLOW = 144 * MiB;
constexpr size_t WS_DEC = 145 * MiB;
constexpr size_t WS_SPV = 146 * MiB;
constexpr size_t WS_KT = 150 * MiB;
constexpr size_t WS_AT = 153 * MiB;
constexpr size_t WS_W1 = 154 * MiB;
constexpr size_t WS_W2 = 170 * MiB;
constexpr size_t WS_YPRE = 186 * MiB;
constexpr size_t WS_SPT = 202 * MiB;
constexpr size_t WS_QE = 234 * MiB;
constexpr size_t WS_KE = 242 * MiB;
constexpr size_t WS_END = 250 * MiB;
constexpr int CW_BAR = 4096;

constexpr int RING_OFF = 0, RING_BYTES = 131072;
constexpr int LDSCTL_OFF = RING_BYTES, MISC_OFF = LDSCTL_OFF + 320;
constexpr int LDS_BYTES = 147456;

struct Args { const float* in[N_IN]; float* out; unsigned char* ws; int ph_lo, ph_hi; };
static_assert(sizeof(Args) == N_IN * 8 + 8 + 8 + 8, "Args has no padding");

struct Frame {
    LAS unsigned char* lds; volatile LAS unsigned* MISC; gu32* ctl;
    int tid, lane, wave, vcu, G;
};

__device__ __forceinline__ float wave_sum(float v) {
#pragma unroll
    for (int o = 1; o < 64; o <<= 1) v += __shfl_xor(v, o);
    return v;
}
__device__ __forceinline__ float bf2f(unsigned short b) { return __builtin_bit_cast(float, ((unsigned)b) << 16); }
__device__ __forceinline__ void store8bf(bf16* p, const float (&v)[8]) {
    v4u w; w.x = pg8::cvt_pk_bf16(v[0], v[1]); w.y = pg8::cvt_pk_bf16(v[2], v[3]); w.z = pg8::cvt_pk_bf16(v[4], v[5]); w.w = pg8::cvt_pk_bf16(v[6], v[7]);
    *(v4u*)p = w;
}
__device__ __forceinline__ void load8bf(const bf16* p, float (&v)[8]) {
    const v4u w = *(const v4u*)p;
    v[0] = __builtin_bit_cast(float, w.x << 16); v[1] = __builtin_bit_cast(float, w.x & 0xffff0000u);
    v[2] = __builtin_bit_cast(float, w.y << 16); v[3] = __builtin_bit_cast(float, w.y & 0xffff0000u);
    v[4] = __builtin_bit_cast(float, w.z << 16); v[5] = __builtin_bit_cast(float, w.z & 0xffff0000u);
    v[6] = __builtin_bit_cast(float, w.w << 16); v[7] = __builtin_bit_cast(float, w.w & 0xffff0000u);
}
__device__ __forceinline__ float sigmoidf_(float x) { return 1.0f / (1.0f + __expf(-x)); }
__device__ __forceinline__ float siluf_(float x) { return x * sigmoidf_(x); }
__device__ __forceinline__ float gelu_tanh(float x) {
    const float z = 0.7978845608028654f * (x + 0.044715f * x * x * x);
    const float t = 1.0f - 2.0f / (1.0f + __expf(2.0f * z));
    return 0.5f * x * (1.0f + t);
}
__device__ __forceinline__ float log_sigmoid(float z) { return fminf(z, 0.f) - log1pf(__expf(-fabsf(z))); }
__device__ __forceinline__ void cexp_dt(float ar, float ai, float dt, float mult, float& re, float& im) {
    const double th = (double)ai * (double)dt * (double)mult;
    const double k = __builtin_rint(th * 0.15915494309189535);
    const float r = (float)(th - k * 6.283185307179586);
    const float mag = expf(ar * dt * mult);
    re = mag * cosf(r); im = mag * sinf(r);
}

struct ProjSink {
    bf16 *UT, *ZS5, *Q, *K, *V, *ZGLA; float* GLOW;
    __device__ __forceinline__ void operator()(int row, int c0, const float (&v)[8]) const {
        if (c0 < 1024) { const int g = c0 >> 4; store8bf(UT + ((size_t)g * NTOK + row) * 16 + (c0 & 15), v); }
        else if (c0 < 2048) { float o[8];
#pragma unroll
            for (int i = 0; i < 8; ++i) o[i] = siluf_(v[i]);
            store8bf(ZS5 + (size_t)row * 1024 + (c0 - 1024), o); }
        else if (c0 < 2560) { float o[8];
#pragma unroll
            for (int i = 0; i < 8; ++i) o[i] = v[i] * 0.08838834764831845f;
            store8bf(Q + (size_t)row * 512 + (c0 - 2048), o); }
        else if (c0 < 3072) store8bf(K + (size_t)row * 512 + (c0 - 2560), v);
        else if (c0 < 4096) store8bf(V + (size_t)row * 1024 + (c0 - 3072), v);
        else if (c0 < 5120) { float o[8];
#pragma unroll
            for (int i = 0; i < 8; ++i) o[i] = siluf_(v[i]);
            store8bf(ZGLA + (size_t)row * 1024 + (c0 - 4096), o); }
        else if (c0 < DIN) { float* p = GLOW + (size_t)row * 16 + (c0 - 5120);
            *(f32x4*)p = (f32x4){v[0], v[1], v[2], v[3]}; *(f32x4*)(p + 4) = (f32x4){v[4], v[5], v[6], v[7]}; }
    }
};
struct GluSink {
    const bf16 *YPRE, *ZS5; const float* glub; bf16* CONCAT;
    __device__ __forceinline__ void operator()(int row, int c0, const float (&v)[8]) const {
        float y[8], g[8], o[8]; load8bf(YPRE + (size_t)row * 1024 + c0, y); load8bf(ZS5 + (size_t)row * 1024 + c0, g);
        const f32x4 b0 = *(const f32x4*)(glub + c0), b1 = *(const f32x4*)(glub + c0 + 4);
        const float b[8] = {b0[0], b0[1], b0[2], b0[3], b1[0], b1[1], b1[2], b1[3]};
#pragma unroll
        for (int i = 0; i < 8; ++i) o[i] = y[i] * sigmoidf_(v[i] + b[i]) * g[i];
        store8bf(CONCAT + (size_t)row * 2048 + c0, o);
    }
};
struct MixSink {
    bf16* MIXED;
    __device__ __forceinline__ void operator()(int row, int c0, const float (&v)[8]) const { store8bf(MIXED + (size_t)row * 2048 + c0, v); }
};

template <class Sink> __device__ __forceinline__ void naive_gemm(const bf16* A, const bf16* Bt, int M, int N, int K, const Sink& s, int gtid, int gthreads) {
    const int n8 = N / 8; const long total = (long)M * n8;
    for (long it = gtid; it < total; it += gthreads) {
        const int c0 = (int)(it % n8) * 8, row = (int)(it / n8);
        float acc[8] = {0.f, 0.f, 0.f, 0.f, 0.f, 0.f, 0.f, 0.f};
        for (int k = 0; k < K; k += 8) {
            float a[8]; load8bf(A + (size_t)row * K + k, a);
#pragma unroll
            for (int i = 0; i < 8; ++i) { float b[8]; load8bf(Bt + (size_t)(c0 + i) * K + k, b);
#pragma unroll
                for (int j = 0; j < 8; ++j) acc[i] += a[j] * b[j]; }
        }
        s(row, c0, acc);
    }
}

__device__ __forceinline__ void p0_transpose_item(const float* W, int K, int N, int Npad, bf16* WT, LAS float* scr, int item, int lane) {
    const int nblk = Npad / 32, kb = item / nblk, nb = item % nblk, k0 = 64 * kb, n0 = 32 * nb;
    const int nl = n0 + (lane & 31); const bool ok = nl < N;
    float tv[32];
#pragma unroll
    for (int i = 0; i < 32; ++i) { const int kk = 2 * i + (lane >> 5); tv[i] = ok ? W[(size_t)(k0 + kk) * N + nl] : 0.f; }
#pragma unroll
    for (int i = 0; i < 32; ++i) { const int kk = 2 * i + (lane >> 5); scr[kk * 33 + (lane & 31)] = tv[i]; }
    LDS_WAIT(); asm volatile("" ::: "memory");
    const int c = lane & 7;
#pragma unroll
    for (int j = 0; j < 4; ++j) { const int n = (lane >> 3) + 8 * j; const LAS float* s = scr + (8 * c) * 33 + n;
        v4u o; o.x = pg8::cvt_pk_bf16(s[0 * 33], s[1 * 33]); o.y = pg8::cvt_pk_bf16(s[2 * 33], s[3 * 33]); o.z = pg8::cvt_pk_bf16(s[4 * 33], s[5 * 33]); o.w = pg8::cvt_pk_bf16(s[6 * 33], s[7 * 33]);
        *(v4u*)(WT + (size_t)(n0 + n) * K + k0 + 8 * c) = o; }
    LDS_WAIT(); asm volatile("" ::: "memory");
}
__device__ __forceinline__ void p0_xn_rows(const float* x, const float* w, bf16* xn, int m0, int mstride, int lane) {
    const f32x4* wr = (const f32x4*)w + lane; f32x4 wv[8];
#pragma unroll
    for (int j = 0; j < 8; ++j) wv[j] = wr[64 * j];
    for (int m = m0; m < NTOK; m += mstride) {
        const f32x4* xr = (const f32x4*)(x + (size_t)m * DM) + lane;
        f32x4 v[8]; float s = 0.f;
#pragma unroll
        for (int j = 0; j < 8; ++j) v[j] = xr[64 * j];
#pragma unroll
        for (int j = 0; j < 8; ++j) s += (v[j].x * v[j].x + v[j].y * v[j].y) + (v[j].z * v[j].z + v[j].w * v[j].w);
        const float rstd = 1.0f / sqrtf(wave_sum(s) * (1.0f / DM) + EPS);
        unsigned long long* o8 = (unsigned long long*)(xn + (size_t)m * DM) + lane;
#pragma unroll
        for (int j = 0; j < 8; ++j) { const f32x4 o = v[j] * rstd * wv[j];
            o8[64 * j] = (unsigned long long)pg8::cvt_pk_bf16(o.x, o.y) | ((unsigned long long)pg8::cvt_pk_bf16(o.z, o.w) << 32); }
    }
}
__device__ __forceinline__ void p0_prologue(const Frame& F, const Args& a) {
    LAS float* scr = (LAS float*)(F.lds + RING_OFF + F.wave * 16384);
    const int gw = F.vcu * NWAVES + F.wave, NGW = F.G * NWAVES;
    constexpr int I_IN = (DM / 64) * (DINP / 32), I_GLU = (DS5 / 64) * (DS5 / 32), I_OUT = (DM / 64) * (DM / 32);
    constexpr int NITEMS = I_IN + I_GLU + I_OUT;
    for (int it = gw; it < NITEMS; it += NGW) {
        int r = it;
        if (r < I_IN) { p0_transpose_item(a.in[I_WIN], DM, DIN, DINP, (bf16*)(a.ws + WS_WIN), scr, r, F.lane); continue; } r -= I_IN;
        if (r < I_GLU) { p0_transpose_item(a.in[I_GLUW], DS5, DS5, DS5, (bf16*)(a.ws + WS_WGLU), scr, r, F.lane); continue; } r -= I_GLU;
        p0_transpose_item(a.in[I_WOUT], DM, DM, DM, (bf16*)(a.ws + WS_WOUT), scr, r, F.lane);
    }
    p0_xn_rows(a.in[I_X], a.in[I_PREW], (bf16*)(a.ws + WS_XN), gw, NGW, F.lane);
}

__device__ __forceinline__ void s5_naive_item(const Args& a, int item, int lane) {
    const int b = item / NGRP, g = item % NGRP, p = lane;
    const float ar = fminf(a.in[I_ARE][g * NST + p], -1e-4f), ai = a.in[I_AIM][g * NST + p];
    const float dt = expf(a.in[I_LOGDT][g]);
    float abr, abi; cexp_dt(ar, ai, dt, 1.0f, abr, abi);
    const float xr = abr - 1.0f, xi = abi, den = 1.0f / (ar * ar + ai * ai);
    const float cr = (xr * ar + xi * ai) * den, ci = (xi * ar - xr * ai) * den;
    float Bbr[GH], Bbi[GH], Ccr[GH], Cci[GH], Dv[GH];
#pragma unroll
    for (int h = 0; h < GH; ++h) {
        const float br = a.in[I_BRE][(g * NST + p) * GH + h], bi = a.in[I_BIM][(g * NST + p) * GH + h];
        Bbr[h] = cr * br - ci * bi; Bbi[h] = cr * bi + ci * br;
        Ccr[h] = a.in[I_CRE][(g * GH + h) * NST + p]; Cci[h] = a.in[I_CIM][(g * GH + h) * NST + p];
        Dv[h] = a.in[I_D][g * GH + h];
    }
    const bf16* U = (const bf16*)(a.ws + WS_UT) + ((size_t)g * NTOK + (size_t)b * SEQ) * 16;
    bf16* Y = (bf16*)(a.ws + WS_YPRE) + (size_t)b * SEQ * DS5 + g * GH;
    float sr = 0.f, si = 0.f;
    for (int t = 0; t < SEQ; ++t) {
        float u[16]; { float u0[8], u1[8]; load8bf(U + (size_t)t * 16, u0); load8bf(U + (size_t)t * 16 + 8, u1);
#pragma unroll
            for (int i = 0; i < 8; ++i) { u[i] = u0[i]; u[8 + i] = u1[i]; } }
        float bur = 0.f, bui = 0.f;
#pragma unroll
        for (int h = 0; h < GH; ++h) { bur += Bbr[h] * u[h]; bui += Bbi[h] * u[h]; }
        const float nr = abr * sr - abi * si + bur, ni = abr * si + abi * sr + bui; sr = nr; si = ni;
        float mine = 0.f;
#pragma unroll
        for (int h = 0; h < GH; ++h) { const float y = wave_sum(Ccr[h] * sr - Cci[h] * si) + Dv[h] * u[h]; mine = (lane == h) ? y : mine; }
        if (lane < GH) { const float o = gelu_tanh(mine); Y[(size_t)t * DS5 + lane] = (bf16)(pg8::cvt_pk_bf16(o, 0.f) & 0xffffu); }
    }
}

__device__ __forceinline__ void gla_naive_item(const Frame& F, const Args& a, int item) {
    const int b = item / NHEAD, h = item % NHEAD, tid = F.tid, dv = tid & 255, half = tid >> 8;
    LAS float* qs = (LAS float*)(F.lds + RING_OFF); LAS float* ks = qs + 128; LAS float* gs = ks + 128; LAS float* part = gs + 128; LAS float* red = part + 512;
    float S[64];
#pragma unroll
    for (int j = 0; j < 64; ++j) S[j] = 0.f;
    float gu[RANK]; float gb = 0.f;
    if (tid < HK) {
#pragma unroll
        for (int r = 0; r < RANK; ++r) gu[r] = a.in[I_GUP][r * GDK + h * HK + tid];
        gb = a.in[I_GBIAS][h * HK + tid];
    } else {
#pragma unroll
        for (int r = 0; r < RANK; ++r) gu[r] = 0.f;
    }
    const float nw = a.in[I_GNORM][dv];
    const bf16* Q = (const bf16*)(a.ws + WS_Q); const bf16* K = (const bf16*)(a.ws + WS_K); const bf16* V = (const bf16*)(a.ws + WS_V);
    const bf16* ZG = (const bf16*)(a.ws + WS_ZGLA); const float* GL = (const float*)(a.ws + WS_GLOW); bf16* CC = (bf16*)(a.ws + WS_CONCAT);
    for (int t = 0; t < SEQ; ++t) {
        const size_t tok = (size_t)b * SEQ + t;
        if (tid < HK) {
            float z = gb;
#pragma unroll
            for (int r = 0; r < RANK; ++r) z += GL[tok * 16 + r] * gu[r];
            gs[tid] = __expf(log_sigmoid(z) * (1.0f / 16.0f));
            qs[tid] = bf2f(Q[tok * GDK + h * HK + tid]); ks[tid] = bf2f(K[tok * GDK + h * HK + tid]);
        }
        __syncthreads();
        const float v = bf2f(V[tok * GDV + h * HV + dv]);
        float o = 0.f;
#pragma unroll
        for (int j = 0; j < 64; ++j) { const int dk = half * 64 + j; S[j] = gs[dk] * S[j] + ks[dk] * v; o += qs[dk] * S[j]; }
        part[tid] = o;
        __syncthreads();
        float ot = 0.f;
        if (half == 0) { ot = part[dv] + part[256 + dv]; const float ss = wave_sum(ot * ot); if (F.lane == 0) red[F.wave] = ss; }
        __syncthreads();
        if (half == 0) { const float tot = (red[0] + red[1]) + (red[2] + red[3]); const float rstd = 1.0f / sqrtf(tot * (1.0f / HV) + EPS);
            const float res = ot * rstd * nw * bf2f(ZG[tok * GDV + h * HV + dv]);
            CC[tok * 2048 + 1024 + h * HV + dv] = (bf16)(pg8::cvt_pk_bf16(res, 0.f) & 0xffffu); }
        __syncthreads();
    }
}

__device__ __forceinline__ void p6_rows(const float* x, const bf16* mixed, const float* pw, float* out, int m0, int mstride, int lane) {
    f32x4 wv[4][2];
#pragma unroll
    for (int j = 0; j < 4; ++j) { const int c = (lane + 64 * j) * 8; wv[j][0] = *(const f32x4*)(pw + c); wv[j][1] = *(const f32x4*)(pw + c + 4); }
    for (int m = m0; m < NTOK; m += mstride) {
        const float* xrow = x + (size_t)m * DM; const bf16* mrow = mixed + (size_t)m * DM; float* orow = out + (size_t)m * DM;
        float mm[4][8]; f32x4 xv[4][2]; float s = 0.f;
#pragma unroll
        for (int j = 0; j < 4; ++j) { const int c = (lane + 64 * j) * 8; load8bf(mrow + c, mm[j]); xv[j][0] = *(const f32x4*)(xrow + c); xv[j][1] = *(const f32x4*)(xrow + c + 4); }
#pragma unroll
        for (int j = 0; j < 4; ++j)
#pragma unroll
            for (int i = 0; i < 8; ++i) s += mm[j][i] * mm[j][i];
        const float rstd = 1.0f / sqrtf(wave_sum(s) * (1.0f / DM) + EPS);
#pragma unroll
        for (int j = 0; j < 4; ++j) { const int c = (lane + 64 * j) * 8;
#pragma unroll
            for (int q = 0; q < 2; ++q) { const f32x4 mv = (f32x4){mm[j][4 * q], mm[j][4 * q + 1], mm[j][4 * q + 2], mm[j][4 * q + 3]};
                *(f32x4*)(orow + c + 4 * q) = xv[j][q] + mv * rstd * wv[j][q]; } }
    }
}

typedef float f32x16 __attribute__((ext_vector_type(16)));
#define MFMA32(a, b, c) __builtin_amdgcn_mfma_f32_32x32x16_bf16((a), (b), (c), 0, 0, 0)
__device__ __forceinline__ f32x16 zero16() { f32x16 z;
#pragma unroll
    for (int i = 0; i < 16; ++i) z[i] = 0.f;
    return z; }
__device__ __forceinline__ bf16x8 pack_step(const f32x16& x, int s) {
    v4u p;
    asm volatile("s_nop 11\n\tv_cvt_pk_bf16_f32 %0, %4, %5\n\tv_cvt_pk_bf16_f32 %1, %6, %7\n\tv_cvt_pk_bf16_f32 %2, %8, %9\n\tv_cvt_pk_bf16_f32 %3, %10, %11\n\ts_nop 1"
                 : "=&v"(p[0]), "=&v"(p[1]), "=&v"(p[2]), "=&v"(p[3])
                 : "v"(x[8 * s]), "v"(x[8 * s + 1]), "v"(x[8 * s + 2]), "v"(x[8 * s + 3]), "v"(x[8 * s + 4]), "v"(x[8 * s + 5]), "v"(x[8 * s + 6]), "v"(x[8 * s + 7]));
    return __builtin_bit_cast(bf16x8, p);
}
__device__ __forceinline__ unsigned short f2bf16(float f) { return (unsigned short)f2bf(f); }

__device__ __forceinline__ void s5_tables(const Frame& F, const Args& a, int g, int qt) {
    LAS float* APr = (LAS float*)(F.lds + RING_OFF); LAS float* APi = APr + 64 * 65;
    LAS float* BBr = APi + 64 * 65; LAS float* BBi = BBr + 1024; LAS float* CCr = BBi + 1024; LAS float* CCi = CCr + 1024; LAS float* P2r = CCi + 1024; LAS float* P2i = P2r + 448;
    const int tid = F.tid;
    const float dt = expf(a.in[I_LOGDT][g]);
    if (tid < 64) {
        const int p = tid;
        const float ar = fminf(a.in[I_ARE][g * NST + p], -1e-4f), ai = a.in[I_AIM][g * NST + p];
        float abr, abi; cexp_dt(ar, ai, dt, 1.0f, abr, abi);
        const float xr = abr - 1.0f, xi = abi, den = 1.0f / (ar * ar + ai * ai);
        const float cr = (xr * ar + xi * ai) * den, ci = (xi * ar - xr * ai) * den;
#pragma unroll
        for (int h = 0; h < GH; ++h) { const float br = a.in[I_BRE][(g * NST + p) * GH + h], bi = a.in[I_BIM][(g * NST + p) * GH + h];
            BBr[p * 16 + h] = cr * br - ci * bi; BBi[p * 16 + h] = cr * bi + ci * br; }
        float qr = abr, qi = abi;
#pragma unroll
        for (int k = 0; k < 7; ++k) { P2r[k * 64 + p] = qr; P2i[k * 64 + p] = qi; const float nr = qr * qr - qi * qi, ni = 2.f * qr * qi; qr = nr; qi = ni; }
    }
    for (int i = tid; i < 1024; i += NTHR) { CCr[i] = a.in[I_CRE][g * 1024 + i]; CCi[i] = a.in[I_CIM][g * 1024 + i]; }
    __syncthreads();
    for (int i = tid; i < 64 * 65; i += NTHR) { const int p = i / 65, d = i - p * 65;
        float r = 1.f, im = 0.f;
#pragma unroll
        for (int k = 0; k < 7; ++k) if ((d >> k) & 1) { const float qr = P2r[k * 64 + p], qi = P2i[k * 64 + p]; const float nr = r * qr - im * qi, ni = r * qi + im * qr; r = nr; im = ni; }
        APr[i] = r; APi[i] = im; }
    __syncthreads();
    { bf16* W2 = (bf16*)(a.ws + WS_W2) + (size_t)g * 1024 * 128;
      for (int it = tid; it < 256 * 16; it += NTHR) { const int row = qt * 256 + (it >> 4), cg = it & 15, t = row >> 4, h = row & 15, ri = cg >> 3, p0 = (cg & 7) * 8;
        float o[8];
#pragma unroll
        for (int e = 0; e < 8; ++e) { const int p = p0 + e; const float cr = CCr[h * 64 + p], ci = CCi[h * 64 + p], pr = APr[p * 65 + t + 1], pi = APi[p * 65 + t + 1];
            o[e] = ri == 0 ? (cr * pr - ci * pi) : -(cr * pi + ci * pr); }
        store8bf(W2 + (size_t)row * 128 + cg * 8, o); } }
    { bf16* KT = (bf16*)(a.ws + WS_KT) + (size_t)g * 65 * 256;
      { const int it = tid; const int d = qt * 16 + (it >> 5), h = (it >> 1) & 15, hh = it & 1;
        float acc[8] = {0.f, 0.f, 0.f, 0.f, 0.f, 0.f, 0.f, 0.f};
        for (int p = 0; p < 64; ++p) { const float cr = CCr[h * 64 + p], ci = CCi[h * 64 + p], pr = APr[p * 65 + d], pi = APi[p * 65 + d];
            const float gr = cr * pr - ci * pi, gi = cr * pi + ci * pr;
#pragma unroll
            for (int e = 0; e < 8; ++e) acc[e] += gr * BBr[p * 16 + 8 * hh + e] - gi * BBi[p * 16 + 8 * hh + e]; }
        store8bf(KT + (size_t)(d + 1) * 256 + h * 16 + 8 * hh, acc); }
      if (qt == 0 && tid < 32) { const float z[8] = {0.f, 0.f, 0.f, 0.f, 0.f, 0.f, 0.f, 0.f}; store8bf(KT + tid * 8, z); } }
    { bf16* W1 = (bf16*)(a.ws + WS_W1) + (size_t)g * 128 * 1024;
      for (int it = tid; it < 32 * 64; it += NTHR) { const int row = qt * 32 + (it >> 6), j = it & 63, p = row & 63, ri = row >> 6;
        const float pr = APr[p * 65 + 63 - j], pi = APi[p * 65 + 63 - j];
        float o0[8], o1[8];
#pragma unroll
        for (int e = 0; e < 8; ++e) { const float b0r = BBr[p * 16 + e], b0i = BBi[p * 16 + e], b1r = BBr[p * 16 + 8 + e], b1i = BBi[p * 16 + 8 + e];
            o0[e] = ri == 0 ? (pr * b0r - pi * b0i) : (pr * b0i + pi * b0r); o1[e] = ri == 0 ? (pr * b1r - pi * b1i) : (pr * b1i + pi * b1r); }
        store8bf(W1 + (size_t)row * 1024 + j * 16, o0); store8bf(W1 + (size_t)row * 1024 + j * 16 + 8, o1); } }
    if (qt == 0 && tid < 64) { float* AT = (float*)(a.ws + WS_AT) + (size_t)(g * 64 + tid) * 2; AT[0] = APr[tid * 65 + 64]; AT[1] = APi[tid * 65 + 64]; }
    __syncthreads();
}

__device__ __forceinline__ void s5_sloc_item(const Frame& F, const Args& a, int item) {
    const int g = item >> 1, b = item & 1, w = F.wave, mt = w >> 1, nt = w & 1, lane = F.lane, r = lane & 31, hf = lane >> 5;
    const bf16* U = (const bf16*)(a.ws + WS_UT) + ((size_t)g * NTOK + (size_t)b * SEQ + (size_t)(nt * 32 + r) * 64) * 16 + 8 * hf;
    const bf16* W1 = (const bf16*)(a.ws + WS_W1) + ((size_t)g * 128 + mt * 32 + r) * 1024 + 8 * hf;
    f32x16 acc = zero16();
#pragma unroll 8
    for (int ks = 0; ks < 64; ++ks) {
        const bf16x8 av = *(const bf16x8*)(U + ks * 16), bv = *(const bf16x8*)(W1 + ks * 16);
        acc = MFMA32(av, bv, acc);
    }
    LAS float* SLL = (LAS float*)(F.lds + RING_OFF);
#pragma unroll
    for (int rr = 0; rr < 16; ++rr) { const int nl = (rr & 3) + 8 * (rr >> 2) + 4 * hf; SLL[(nt * 32 + nl) * 128 + mt * 32 + r] = acc[rr]; }
    __syncthreads();
    if (w == 0) {
        const float* AT = (const float*)(a.ws + WS_AT) + (size_t)(g * 64 + lane) * 2; const float atr = AT[0], ati = AT[1];
        unsigned short* SPV = (unsigned short*)(a.ws + WS_SPV) + ((size_t)g * 128 + b * 64) * 128;
        float sr = 0.f, si = 0.f;
#pragma unroll 4
        for (int c = 0; c < 64; ++c) {
            SPV[(size_t)c * 128 + lane] = f2bf16(sr); SPV[(size_t)c * 128 + 64 + lane] = f2bf16(si);
            const float lr = SLL[c * 128 + lane], li = SLL[c * 128 + 64 + lane];
            const float nr = atr * sr - ati * si + lr, ni = atr * si + ati * sr + li; sr = nr; si = ni; }
    }
    __syncthreads();
}

constexpr int S5_KTL = 0, S5_UL = 33280, S5_ULROW = 2064, S5_SPL = S5_UL + 32 * S5_ULROW, S5_SPROW = 272;
__device__ __forceinline__ void s5_main_item(const Frame& F, const Args& a, int item) {
    const int g = item >> 2, b = (item >> 1) & 1, nt = item & 1, tid = F.tid, w = F.wave, lane = F.lane, r = lane & 31, hf = lane >> 5;
    LAS unsigned char* L = F.lds + RING_OFF;
    { const v4u* src = (const v4u*)((const bf16*)(a.ws + WS_KT) + (size_t)g * 65 * 256);
      for (int i = tid; i < 2080; i += NTHR) *(LAS v4u*)(L + S5_KTL + i * 16) = src[i];
      const v4u* us = (const v4u*)((const bf16*)(a.ws + WS_UT) + ((size_t)g * NTOK + (size_t)b * SEQ + (size_t)nt * 32 * 64) * 16);
#pragma unroll
      for (int i = 0; i < 8; ++i) { const int idx = tid + NTHR * i, row = idx >> 7, c16 = idx & 127; *(LAS v4u*)(L + S5_UL + row * S5_ULROW + c16 * 16) = us[idx]; } }
    { const v4u* sp = (const v4u*)((const bf16*)(a.ws + WS_SPV) + ((size_t)g * 128 + b * 64 + nt * 32) * 128);
      *(LAS v4u*)(L + S5_SPL + (tid >> 4) * S5_SPROW + (tid & 15) * 16) = sp[tid]; }
    __syncthreads();
    const bf16* W2 = (const bf16*)(a.ws + WS_W2) + (size_t)g * 1024 * 128;
    const bf16* UT = (const bf16*)(a.ws + WS_UT) + ((size_t)g * NTOK + (size_t)b * SEQ + (size_t)(nt * 32 + r) * 64) * 16;
    bf16* YP = (bf16*)(a.ws + WS_YPRE) + ((size_t)b * SEQ + (size_t)(nt * 32 + r) * 64) * DS5 + g * GH;
    const LAS unsigned char* aL = L + S5_KTL + r * 32 + hf * 16;
    const LAS unsigned char* bL = L + S5_UL + r * S5_ULROW + hf * 16;
    const LAS unsigned char* sL = L + S5_SPL + r * S5_SPROW + hf * 16;
#pragma unroll 1
    for (int q = 0; q < 4; ++q) {
        const int tb = (q == 0) ? w : (q == 1) ? 15 - w : (q == 2) ? 16 + w : 31 - w;
        bf16x8 wa[8];
        { const bf16* wp = W2 + (size_t)(tb * 32 + r) * 128 + 8 * hf;
#pragma unroll
          for (int ks = 0; ks < 8; ++ks) wa[ks] = *(const bf16x8*)(wp + ks * 16); }
        f32x16 acc = zero16();
        const int nj = 2 * tb + 2;
#pragma unroll 2
        for (int j = 0; j < nj; ++j) {
            const bf16x8 av = *(const LAS bf16x8*)(aL + (2 * tb - j + 1) * 512), bv = *(const LAS bf16x8*)(bL + j * 32);
            acc = MFMA32(av, bv, acc);
        }
#pragma unroll
        for (int ks = 0; ks < 8; ++ks) { const bf16x8 bv = *(const LAS bf16x8*)(sL + ks * 32); acc = MFMA32(wa[ks], bv, acc); }
#pragma unroll
        for (int qq = 0; qq < 4; ++qq) { const int t = 2 * tb + (qq >> 1), h0 = 8 * (qq & 1) + 4 * hf;
            const unsigned long long uw = *(const unsigned long long*)(UT + (size_t)t * 16 + h0);
            const f32x4 dv = *(const f32x4*)(a.in[I_D] + g * GH + h0);
            const float u0 = __builtin_bit_cast(float, (unsigned)(uw << 16)), u1 = __builtin_bit_cast(float, (unsigned)uw & 0xffff0000u),
                        u2 = __builtin_bit_cast(float, (unsigned)(uw >> 32) << 16), u3 = __builtin_bit_cast(float, (unsigned)(uw >> 32) & 0xffff0000u);
            const float y0 = gelu_tanh(acc[4 * qq] + dv[0] * u0), y1 = gelu_tanh(acc[4 * qq + 1] + dv[1] * u1), y2 = gelu_tanh(acc[4 * qq + 2] + dv[2] * u2), y3 = gelu_tanh(acc[4 * qq + 3] + dv[3] * u3);
            *(unsigned long long*)(YP + (size_t)t * DS5 + h0) = (unsigned long long)pg8::cvt_pk_bf16(y0, y1) | ((unsigned long long)pg8::cvt_pk_bf16(y2, y3) << 32); }
    }
    __syncthreads();
}

__device__ __forceinline__ float log_sigmoid_fast(float z) { return fminf(z, 0.f) - __logf(1.0f + __expf(-fabsf(z))); }
__device__ __forceinline__ bf16x8 gla_vfrag(const LAS unsigned short* VL, int sbase, int col, bool perm) {
    unsigned short x[8];
#pragma unroll
    for (int e = 0; e < 8; ++e) { const int s = perm ? (sbase + 8 * (e >> 2) + (e & 3)) : (sbase + e); x[e] = VL[s * 256 + col]; }
    v4u p; p.x = (unsigned)x[0] | ((unsigned)x[1] << 16); p.y = (unsigned)x[2] | ((unsigned)x[3] << 16); p.z = (unsigned)x[4] | ((unsigned)x[5] << 16); p.w = (unsigned)x[6] | ((unsigned)x[7] << 16);
    return __builtin_bit_cast(bf16x8, p);
}

constexpr int GL_TOT = 0, GL_GLW = 2048, GL_QL = 6144, GL_ROW = 272, GL_KL = GL_QL + 64 * GL_ROW, GL_KTT = GL_KL + 64 * GL_ROW, GL_KTROW = 144, GL_VL = GL_KTT + 128 * GL_KTROW;
static_assert(GL_VL + 32768 <= RING_BYTES, "GLA kv LDS map");
__device__ __forceinline__ void gla_kv_item(const Frame& F, const Args& a, int n) {
    const int bh = n >> 6, c = n & 63, b = bh >> 2, h = bh & 3, tid = F.tid, dk = tid & 127, tq = tid >> 7, w = F.wave, lane = F.lane, r = lane & 31, hf = lane >> 5;
    const size_t tok0 = (size_t)b * SEQ + (size_t)c * 64;
    LAS unsigned char* L = F.lds + RING_OFF;
    { const bf16* Q = (const bf16*)(a.ws + WS_Q) + tok0 * GDK + h * HK; const bf16* K = (const bf16*)(a.ws + WS_K) + tok0 * GDK + h * HK; const bf16* V = (const bf16*)(a.ws + WS_V) + tok0 * GDV + h * HV;
      v4u gq[2], gk[2], gv[4], gg;
#pragma unroll
      for (int i = 0; i < 2; ++i) { const int idx = tid + NTHR * i, row = idx >> 4, c16 = idx & 15; gq[i] = *(const v4u*)(Q + (size_t)row * GDK + c16 * 8); gk[i] = *(const v4u*)(K + (size_t)row * GDK + c16 * 8); }
#pragma unroll
      for (int i = 0; i < 4; ++i) { const int idx = tid + NTHR * i, row = idx >> 5, c16 = idx & 31; gv[i] = *(const v4u*)(V + (size_t)row * GDV + c16 * 8); }
      gg = (tid < 256) ? ((const v4u*)((const float*)(a.ws + WS_GLOW) + tok0 * 16))[tid] : (v4u){0u, 0u, 0u, 0u};
#pragma unroll
      for (int i = 0; i < 2; ++i) { const int idx = tid + NTHR * i, row = idx >> 4, c16 = idx & 15; *(LAS v4u*)(L + GL_QL + row * GL_ROW + c16 * 16) = gq[i]; *(LAS v4u*)(L + GL_KL + row * GL_ROW + c16 * 16) = gk[i]; }
#pragma unroll
      for (int i = 0; i < 4; ++i) { const int idx = tid + NTHR * i, row = idx >> 5, c16 = idx & 31; *(LAS v4u*)(L + GL_VL + row * 512 + c16 * 16) = gv[i]; }
      if (tid < 256) *(LAS v4u*)(L + GL_GLW + tid * 16) = gg; }
    float gu[RANK];
#pragma unroll
    for (int rr = 0; rr < RANK; ++rr) gu[rr] = a.in[I_GUP][rr * GDK + h * HK + dk];
    const float gb = a.in[I_GBIAS][h * HK + dk];
    __syncthreads();
    float bl[16]; float run = 0.f;
    { const LAS f32x4* GW = (const LAS f32x4*)(L + GL_GLW) + tq * 64;
#pragma unroll
      for (int i = 0; i < 16; ++i) { const f32x4 g0 = GW[i * 4], g1 = GW[i * 4 + 1], g2 = GW[i * 4 + 2], g3 = GW[i * 4 + 3];
        float z = gb;
        z += g0[0] * gu[0]; z += g0[1] * gu[1]; z += g0[2] * gu[2]; z += g0[3] * gu[3]; z += g1[0] * gu[4]; z += g1[1] * gu[5]; z += g1[2] * gu[6]; z += g1[3] * gu[7];
        z += g2[0] * gu[8]; z += g2[1] * gu[9]; z += g2[2] * gu[10]; z += g2[3] * gu[11]; z += g3[0] * gu[12]; z += g3[1] * gu[13]; z += g3[2] * gu[14]; z += g3[3] * gu[15];
        run += log_sigmoid_fast(z) * (1.0f / 16.0f); bl[i] = run; } }
    LAS float* TOT = (LAS float*)(L + GL_TOT);
    TOT[tq * 128 + dk] = run;
    __syncthreads();
    const float t0 = TOT[dk], t1 = TOT[128 + dk], t2 = TOT[256 + dk], t3 = TOT[384 + dk];
    const float off = (tq > 0 ? t0 : 0.f) + (tq > 1 ? t1 : 0.f) + (tq > 2 ? t2 : 0.f);
    const float blast = (t0 + t1) + (t2 + t3), elast = __expf(blast);
    { float kt[16];
#pragma unroll
      for (int i = 0; i < 16; ++i) { const float e = __expf(bl[i] + off), ei = __builtin_amdgcn_rcpf(e);
          LAS unsigned short* qp = (LAS unsigned short*)(L + GL_QL + (tq * 16 + i) * GL_ROW + dk * 2); LAS unsigned short* kp = (LAS unsigned short*)(L + GL_KL + (tq * 16 + i) * GL_ROW + dk * 2);
          const float ke = bf2f(*kp) * ei;
          *qp = f2bf16(bf2f(*qp) * e); *kp = f2bf16(ke); kt[i] = ke * elast; }
      v4u p0, p1; p0.x = pg8::cvt_pk_bf16(kt[0], kt[1]); p0.y = pg8::cvt_pk_bf16(kt[2], kt[3]); p0.z = pg8::cvt_pk_bf16(kt[4], kt[5]); p0.w = pg8::cvt_pk_bf16(kt[6], kt[7]);
      p1.x = pg8::cvt_pk_bf16(kt[8], kt[9]); p1.y = pg8::cvt_pk_bf16(kt[10], kt[11]); p1.z = pg8::cvt_pk_bf16(kt[12], kt[13]); p1.w = pg8::cvt_pk_bf16(kt[14], kt[15]);
      *(LAS v4u*)(L + GL_KTT + dk * GL_KTROW + tq * 32) = p0; *(LAS v4u*)(L + GL_KTT + dk * GL_KTROW + tq * 32 + 16) = p1;
      if (tq == 0) ((float*)(a.ws + WS_DEC))[(size_t)n * HK + dk] = elast; }
    __syncthreads();
    { bf16* QE = (bf16*)(a.ws + WS_QE) + (size_t)n * 64 * HK; bf16* KE = (bf16*)(a.ws + WS_KE) + (size_t)n * 64 * HK;
#pragma unroll
      for (int i = 0; i < 2; ++i) { const int idx = tid + NTHR * i, row = idx >> 4, c16 = idx & 15;
          *(v4u*)(QE + row * HK + c16 * 8) = *(const LAS v4u*)(L + GL_QL + row * GL_ROW + c16 * 16); *(v4u*)(KE + row * HK + c16 * 8) = *(const LAS v4u*)(L + GL_KL + row * GL_ROW + c16 * 16); } }
    f32x16 acc[4];
#pragma unroll
    for (int d = 0; d < 4; ++d) acc[d] = zero16();
#pragma unroll
    for (int ks = 0; ks < 4; ++ks) {
        const bf16x8 av = gla_vfrag((const LAS unsigned short*)(L + GL_VL), 16 * ks + 8 * hf, w * 32 + r, false);
#pragma unroll
        for (int d = 0; d < 4; ++d) { const bf16x8 bv = *(const LAS bf16x8*)(L + GL_KTT + (d * 32 + r) * GL_KTROW + ks * 32 + hf * 16); acc[d] = MFMA32(av, bv, acc[d]); }
    }
    bf16* KVT = (bf16*)(a.ws + WS_KVT) + ((size_t)n * HV + w * 32) * HK + r;
#pragma unroll
    for (int d = 0; d < 4; ++d)
#pragma unroll
        for (int rr = 0; rr < 16; ++rr) { const int dvl = (rr & 3) + 8 * (rr >> 2) + 4 * hf; KVT[(size_t)dvl * HK + d * 32] = f2bf16(acc[d][rr]); }
    __syncthreads();
}

__device__ __forceinline__ void gla_scan(const Args& a, int gtid, int gthreads) {
    for (int e2 = gtid; e2 < 8 * 256 * 64; e2 += gthreads) {
        const int bh = e2 >> 14, rem = e2 & 16383;
        const unsigned* KV = (const unsigned*)(a.ws + WS_KVT) + (size_t)bh * 64 * 16384 + rem;
        unsigned* SP = (unsigned*)(a.ws + WS_SPT) + (size_t)bh * 64 * 16384 + rem;
        const float* DEC = (const float*)(a.ws + WS_DEC) + (size_t)bh * 64 * HK + 2 * (rem & 63);
        float s0 = 0.f, s1 = 0.f;
#pragma unroll 1
        for (int cb = 0; cb < 8; ++cb) {
            unsigned kv[8]; float d0[8], d1[8];
#pragma unroll
            for (int i = 0; i < 8; ++i) { const int c = cb * 8 + i; kv[i] = KV[(size_t)c * 16384]; d0[i] = DEC[c * HK]; d1[i] = DEC[c * HK + 1]; }
#pragma unroll
            for (int i = 0; i < 8; ++i) { const int c = cb * 8 + i;
                SP[(size_t)c * 16384] = pg8::cvt_pk_bf16(s0, s1);
                s0 = d0[i] * s0 + __builtin_bit_cast(float, kv[i] << 16); s1 = d1[i] * s1 + __builtin_bit_cast(float, kv[i] & 0xffff0000u); }
        }
    }
}

constexpr int GO_QE = 0, GO_ROW = 272, GO_KE = GO_QE + 64 * GO_ROW, GO_VL = GO_KE + 64 * GO_ROW, GO_RED = GO_VL + 32768, GO_RS = GO_RED + 2048;
__device__ __forceinline__ void gla_out_item(const Frame& F, const Args& a, int n) {
    const int bh = n >> 6, c = n & 63, b = bh >> 2, h = bh & 3, tid = F.tid, w = F.wave, lane = F.lane, r = lane & 31, hf = lane >> 5;
    const size_t tok0 = (size_t)b * SEQ + (size_t)c * 64;
    LAS unsigned char* L = F.lds + RING_OFF;
    bf16x8 sa[8]; unsigned long long zw[2][4];
    { const bf16* QE = (const bf16*)(a.ws + WS_QE) + (size_t)n * 64 * HK; const bf16* KE = (const bf16*)(a.ws + WS_KE) + (size_t)n * 64 * HK; const bf16* V = (const bf16*)(a.ws + WS_V) + tok0 * GDV + h * HV;
      v4u gq[2], gk[2], gv[4];
#pragma unroll
      for (int i = 0; i < 2; ++i) { const int idx = tid + NTHR * i; gq[i] = ((const v4u*)QE)[idx]; gk[i] = ((const v4u*)KE)[idx]; }
#pragma unroll
      for (int i = 0; i < 4; ++i) { const int idx = tid + NTHR * i, row = idx >> 5, c16 = idx & 31; gv[i] = *(const v4u*)(V + (size_t)row * GDV + c16 * 8); }
      const bf16* SP = (const bf16*)(a.ws + WS_SPT) + ((size_t)n * HV + w * 32 + r) * HK + 8 * hf;
#pragma unroll
      for (int ks = 0; ks < 8; ++ks) sa[ks] = *(const bf16x8*)(SP + ks * 16);
      const bf16* ZG = (const bf16*)(a.ws + WS_ZGLA);
#pragma unroll
      for (int bb = 0; bb < 2; ++bb)
#pragma unroll
          for (int qq = 0; qq < 4; ++qq) zw[bb][qq] = *(const unsigned long long*)(ZG + (tok0 + bb * 32 + r) * GDV + h * HV + w * 32 + 8 * qq + 4 * hf);
#pragma unroll
      for (int i = 0; i < 2; ++i) { const int idx = tid + NTHR * i, row = idx >> 4, c16 = idx & 15; *(LAS v4u*)(L + GO_QE + row * GO_ROW + c16 * 16) = gq[i]; *(LAS v4u*)(L + GO_KE + row * GO_ROW + c16 * 16) = gk[i]; }
#pragma unroll
      for (int i = 0; i < 4; ++i) { const int idx = tid + NTHR * i, row = idx >> 5, c16 = idx & 31; *(LAS v4u*)(L + GO_VL + row * 512 + c16 * 16) = gv[i]; } }
    __syncthreads();
    f32x16 x00 = zero16(), x01 = zero16(), x11 = zero16();
#pragma unroll
    for (int ks = 0; ks < 8; ++ks) {
        const bf16x8 ka0 = *(const LAS bf16x8*)(L + GO_KE + r * GO_ROW + ks * 32 + hf * 16), ka1 = *(const LAS bf16x8*)(L + GO_KE + (32 + r) * GO_ROW + ks * 32 + hf * 16);
        const bf16x8 qb0 = *(const LAS bf16x8*)(L + GO_QE + r * GO_ROW + ks * 32 + hf * 16), qb1 = *(const LAS bf16x8*)(L + GO_QE + (32 + r) * GO_ROW + ks * 32 + hf * 16);
        x00 = MFMA32(ka0, qb0, x00); x01 = MFMA32(ka0, qb1, x01); x11 = MFMA32(ka1, qb1, x11);
    }
#pragma unroll
    for (int rr = 0; rr < 16; ++rr) { const int sl = (rr & 3) + 8 * (rr >> 2) + 4 * hf; if (sl > r) { x00[rr] = 0.f; x11[rr] = 0.f; } }
    f32x16 ot0 = zero16(), ot1 = zero16();
    const LAS unsigned short* VL = (const LAS unsigned short*)(L + GO_VL);
#pragma unroll
    for (int kk = 0; kk < 2; ++kk) {
        const bf16x8 va0 = gla_vfrag(VL, 16 * kk + 4 * hf, w * 32 + r, true), va1 = gla_vfrag(VL, 32 + 16 * kk + 4 * hf, w * 32 + r, true);
        ot0 = MFMA32(va0, pack_step(x00, kk), ot0);
        ot1 = MFMA32(va0, pack_step(x01, kk), ot1);
        ot1 = MFMA32(va1, pack_step(x11, kk), ot1);
    }
#pragma unroll
    for (int ks = 0; ks < 8; ++ks) {
        const bf16x8 qb0 = *(const LAS bf16x8*)(L + GO_QE + r * GO_ROW + ks * 32 + hf * 16), qb1 = *(const LAS bf16x8*)(L + GO_QE + (32 + r) * GO_ROW + ks * 32 + hf * 16);
        ot0 = MFMA32(sa[ks], qb0, ot0); ot1 = MFMA32(sa[ks], qb1, ot1); }
    { float s0 = 0.f, s1 = 0.f;
#pragma unroll
      for (int rr = 0; rr < 16; ++rr) { s0 += ot0[rr] * ot0[rr]; s1 += ot1[rr] * ot1[rr]; }
      s0 += __shfl_xor(s0, 32); s1 += __shfl_xor(s1, 32);
      LAS float* RED = (LAS float*)(L + GO_RED);
      if (hf == 0) { RED[w * 64 + r] = s0; RED[w * 64 + 32 + r] = s1; } }
    __syncthreads();
    if (tid < 64) { const LAS float* RED = (const LAS float*)(L + GO_RED); float t = 0.f;
#pragma unroll
        for (int ww = 0; ww < 8; ++ww) t += RED[ww * 64 + tid];
        ((LAS float*)(L + GO_RS))[tid] = 1.0f / sqrtf(t * (1.0f / HV) + EPS); }
    __syncthreads();
    { const LAS float* RS = (const LAS float*)(L + GO_RS); const float rs0 = RS[r], rs1 = RS[32 + r];
      bf16* CC = (bf16*)(a.ws + WS_CONCAT);
#pragma unroll
      for (int bb = 0; bb < 2; ++bb) { const size_t tok = tok0 + bb * 32 + r; const float rs = bb ? rs1 : rs0;
#pragma unroll
          for (int qq = 0; qq < 4; ++qq) { const int dv = w * 32 + 8 * qq + 4 * hf;
              const f32x4 nw = *(const f32x4*)(a.in[I_GNORM] + dv);
              const unsigned long long z = zw[bb][qq];
              const float z0 = __builtin_bit_cast(float, (unsigned)(z << 16)), z1 = __builtin_bit_cast(float, (unsigned)z & 0xffff0000u),
                          z2 = __builtin_bit_cast(float, (unsigned)(z >> 32) << 16), z3 = __builtin_bit_cast(float, (unsigned)(z >> 32) & 0xffff0000u);
              const f32x16& o = bb ? ot1 : ot0;
              const float y0 = o[4 * qq] * rs * nw[0] * z0, y1 = o[4 * qq + 1] * rs * nw[1] * z1, y2 = o[4 * qq + 2] * rs * nw[2] * z2, y3 = o[4 * qq + 3] * rs * nw[3] * z3;
              *(unsigned long long*)(CC + tok * 2048 + 1024 + h * HV + dv) = (unsigned long long)pg8::cvt_pk_bf16(y0, y1) | ((unsigned long long)pg8::cvt_pk_bf16(y2, y3) << 32); } } }
    __syncthreads();
}

constexpr int NPHASE = 7;
__global__ void __launch_bounds__(NTHR, 2) mega_fwd(Args a) {
    extern __shared__ __attribute__((aligned(16))) unsigned char lds[];
    Frame F;
    F.lds = (LAS unsigned char*)lds; F.MISC = (volatile LAS unsigned*)(F.lds + MISC_OFF);
    F.tid = threadIdx.x; F.lane = F.tid & 63; F.wave = __builtin_amdgcn_readfirstlane(F.tid >> 6);
    F.G = gridDim.x; { const int bx = blockIdx.x; F.vcu = (F.G % 8 == 0) ? (bx % 8) * (F.G / 8) + bx / 8 : bx; }
    F.ctl = (gu32*)(a.ws + WS_CTL);
    for (int u = F.tid; u < (LDS_BYTES - LDSCTL_OFF) / 4; u += NTHR) ((LAS unsigned*)(F.lds + LDSCTL_OFF))[u] = 0u;
    __syncthreads();
    const int lo = a.ph_lo, hi = a.ph_hi;
    const bool use_bar = (hi - lo) > 1;
    XcdBarrier bar; bar.bar = (unsigned*)(F.ctl + CW_BAR); bar.x = 0; bar.st = nullptr;
    if (use_bar) bar = xcd_barrier_post((unsigned*)(F.ctl + CW_BAR), F.MISC + 8);
#define IN(k) (lo <= (k) && (k) < hi)
#define SEAM(k) do { if (IN(k) && IN((k) + 1)) xcd_barrier(bar); } while (0)
    const int gtid = blockIdx.x * NTHR + F.tid, gthreads = F.G * NTHR;
    const int gw = blockIdx.x * NWAVES + F.wave, NGW = F.G * NWAVES;
    unsigned char* ws = a.ws;

    for (int rep_ = 0; rep_ < ((0 == REP_PHASE) ? 2 : 1); ++rep_) { if (rep_ == 1 && use_bar) xcd_barrier(bar);
    if (IN(0)) {
#if FAST_S5
        for (int it = (int)blockIdx.x; it < 256; it += F.G) s5_tables(F, a, it >> 2, it & 3);
#endif
        p0_prologue(F, a);
    }
    }
    SEAM(0);

    for (int rep_ = 0; rep_ < ((1 == REP_PHASE) ? 2 : 1); ++rep_) { if (rep_ == 1 && use_bar) xcd_barrier(bar);
    if (IN(1)) {
        ProjSink ps{(bf16*)(ws + WS_UT), (bf16*)(ws + WS_ZS5), (bf16*)(ws + WS_Q), (bf16*)(ws + WS_K), (bf16*)(ws + WS_V), (bf16*)(ws + WS_ZGLA), (float*)(ws + WS_GLOW)};
#if FAST_GEMM
        pg8::Gemm g{(const pg8::bf16_t*)(ws + WS_XN), (const pg8::bf16_t*)(ws + WS_WIN), NTOK, DINP, DM}; pg8::StaticOrder S; S.init(NTOK, DINP, F.G, (int)blockIdx.x);
        pg8::Epi8<ProjSink> E{ps};
        pg8::gemm_phase<pg8::Epi8<ProjSink>, pg8::StaticOrder, PG8_ALIGN, PG8_SP2>(F.lds + RING_OFF, g, S, E);
#else
        naive_gemm((const bf16*)(ws + WS_XN), (const bf16*)(ws + WS_WIN), NTOK, DINP, DM, ps, gtid, gthreads);
#endif
    }
    }
    SEAM(1);

    for (int rep_ = 0; rep_ < ((2 == REP_PHASE) ? 2 : 1); ++rep_) { if (rep_ == 1 && use_bar) xcd_barrier(bar);
    if (IN(2)) {
#if FAST_GLA
        for (int n = (int)blockIdx.x; n < 512; n += F.G) gla_kv_item(F, a, n);
#endif
#if FAST_S5
        for (int it = (int)blockIdx.x; it < 128; it += F.G) s5_sloc_item(F, a, it);
#endif
    }
    }
    SEAM(2);

    for (int rep_ = 0; rep_ < ((3 == REP_PHASE) ? 2 : 1); ++rep_) { if (rep_ == 1 && use_bar) xcd_barrier(bar);
    if (IN(3)) {
#if FAST_S5
        for (int it = (int)blockIdx.x; it < 256; it += F.G) s5_main_item(F, a, it);
#else
        if (blockIdx.x >= 8 && blockIdx.x < 8 + 16) s5_naive_item(a, ((int)blockIdx.x - 8) * NWAVES + F.wave, F.lane);
#endif
#if FAST_GLA
        gla_scan(a, gtid, gthreads);
#else
        if (blockIdx.x < 8) gla_naive_item(F, a, (int)blockIdx.x);
#endif
    }
    }
    SEAM(3);

    for (int rep_ = 0; rep_ < ((4 == REP_PHASE) ? 2 : 1); ++rep_) { if (rep_ == 1 && use_bar) xcd_barrier(bar);
    if (IN(4)) {
        GluSink gs{(const bf16*)(ws + WS_YPRE), (const bf16*)(ws + WS_ZS5), a.in[I_GLUB], (bf16*)(ws + WS_CONCAT)};
#if FAST_GEMM
        pg8::Gemm g{(const pg8::bf16_t*)(ws + WS_YPRE), (const pg8::bf16_t*)(ws + WS_WGLU), NTOK, DS5, DS5}; pg8::StaticOrder S; S.init(NTOK, DS5, F.G, (int)blockIdx.x);
        pg8::Epi8<GluSink> E{gs};
        pg8::gemm_phase<pg8::Epi8<GluSink>, pg8::StaticOrder, PG8_ALIGN, PG8_SP2>(F.lds + RING_OFF, g, S, E);
#else
        naive_gemm((const bf16*)(ws + WS_YPRE), (const bf16*)(ws + WS_WGLU), NTOK, DS5, DS5, gs, gtid, gthreads);
#endif
#if FAST_GLA
        __syncthreads();
        if (F.G == 256) { if (blockIdx.x >= 128) for (int n = (int)blockIdx.x - 128; n < 512; n += 128) gla_out_item(F, a, n); }
        else for (int n = (int)blockIdx.x; n < 512; n += F.G) gla_out_item(F, a, n);
#endif
    }
    }
    SEAM(4);

    for (int rep_ = 0; rep_ < ((5 == REP_PHASE) ? 2 : 1); ++rep_) { if (rep_ == 1 && use_bar) xcd_barrier(bar);
    if (IN(5)) {
        MixSink ms{(bf16*)(ws + WS_MIXED)};
#if FAST_GEMM
        pg8::Gemm g{(const pg8::bf16_t*)(ws + WS_CONCAT), (const pg8::bf16_t*)(ws + WS_WOUT), NTOK, DM, DM}; pg8::StaticOrder S; S.init(NTOK, DM, F.G, (int)blockIdx.x);
        pg8::Epi8<MixSink> E{ms};
        pg8::gemm_phase<pg8::Epi8<MixSink>, pg8::StaticOrder, PG8_ALIGN, PG8_SP2>(F.lds + RING_OFF, g, S, E);
#else
        naive_gemm((const bf16*)(ws + WS_CONCAT), (const bf16*)(ws + WS_WOUT), NTOK, DM, DM, ms, gtid, gthreads);
#endif
    }
    }
    SEAM(5);

    for (int rep_ = 0; rep_ < ((6 == REP_PHASE) ? 2 : 1); ++rep_) { if (rep_ == 1 && use_bar) xcd_barrier(bar);
    if (IN(6)) {
        p6_rows(a.in[I_X], (const bf16*)(ws + WS_MIXED), a.in[I_POSTW], a.out, gw, NGW, F.lane);
    }
    }
#undef IN
#undef SEAM
}

extern "C" void kernel_launch(void* const* d_in, const int* in_sizes, int n_in, void* d_out, int out_size, void* d_ws, size_t ws_size, hipStream_t stream) {
    static int grid = 0;
    if (grid == 0) {
        if (n_in != N_IN || out_size != NTOK * DM || ws_size < WS_END) { fprintf(stderr, "kernel_launch: unexpected problem shape (n_in %d out %d ws %zu)\n", n_in, out_size, ws_size); grid = -1; return; }
        int dev = 0, cus = 0;
        if (hipGetDevice(&dev) != hipSuccess || hipDeviceGetAttribute(&cus, hipDeviceAttributeMultiprocessorCount, dev) != hipSuccess) { grid = -1; return; }
        if (hipFuncSetAttribute((const void*)mega_fwd, hipFuncAttributeMaxDynamicSharedMemorySize, LDS_BYTES) != hipSuccess) { fprintf(stderr, "kernel_launch: hipFuncSetAttribute failed\n"); grid = -1; return; }
        grid = cus;
    }
    if (grid < 0) return;
    (void)hipMemsetAsync((char*)d_ws + WS_CTL, 0, CTL_ZERO_BYTES, stream);
    Args a{};
    for (int i = 0; i < N_IN; ++i) a.in[i] = (const float*)d_in[i];
    a.out = (float*)d_out; a.ws = (unsigned char*)d_ws;
#if MK_ONE_LAUNCH
    a.ph_lo = 0; a.ph_hi = NPHASE;
    hipLaunchKernelGGL(mega_fwd, dim3(grid), dim3(NTHR), LDS_BYTES, stream, a);
#else
    for (int p = 0; p < NPHASE; ++p) {
        if (p == 2 && !(FAST_S5 || FAST_GLA)) continue;
        a.ph_lo = p; a.ph_hi = p + 1;
        hipLaunchKernelGGL(mega_fwd, dim3(grid), dim3(NTHR), LDS_BYTES, stream, a);
        if (p == DUP_PHASE) hipLaunchKernelGGL(mega_fwd, dim3(grid), dim3(NTHR), LDS_BYTES, stream, a);
    }
#endif
}
```

```cpp
#include <hip/hip_runtime.h>
#include <cstdio>
#include <cstdint>

#define MK_ONE_LAUNCH 1
#define FAST_GEMM 1
#define FAST_S5 1
#define FAST_GLA 1
#define DUP_PHASE -1
#define REP_PHASE -1

namespace pg8 {
#define PG8_LAS __attribute__((address_space(3)))
typedef unsigned short bf16_t;
typedef short bf16x8 __attribute__((ext_vector_type(8)));
typedef float f32x4 __attribute__((ext_vector_type(4)));
typedef unsigned u32x4 __attribute__((ext_vector_type(4)));
constexpr int BM = 256, BK = 64, HALF = 128, HTB = HALF * BK * 2  , STAGE_BYTES = 8 * HTB, NXCD = 8, WGM = 8;

__host__ __device__ __forceinline__ int lds_byte(int r, int c) { const int st = (r >> 4) * 2 + (c >> 5), rr = r & 15, cc = c & 31, ob = rr * 64 + cc * 2; return st * 1024 + (ob ^ (((ob >> 9) & 1) << 5)); }
__host__ __device__ __forceinline__ void stage_rc(int b, int& R, int& C) { const int st = b / 1024, sb = b % 1024, swz = sb ^ (((sb >> 9) & 1) << 5); R = (st >> 1) * 16 + swz / 64; C = (st & 1) * 32 + (swz % 64) / 2; }
__host__ __device__ __forceinline__ int perm32(int rho) { const int n = rho >> 4, i = rho & 15; return 8 * (i >> 2) + 4 * n + (i & 3); }

struct Unit { int pm, pn; };
struct Gemm { const bf16_t* A; const bf16_t* Bt; int M, N, K; };

struct StaticOrder {
    int nM, nN, nwg, G, c;
    __host__ __device__ void init(int M, int N, int G_, int c_) { nM = M / BM; nN = N / BM; nwg = nM * nN; G = G_; c = c_; }
    __host__ __device__ bool next(int i, Unit& u) const {
        const long L = (long)i * G + c; if (L >= nwg) return false;
        int wgid = (int)L; { const int q = nwg / NXCD, r = nwg % NXCD, xcd = wgid % NXCD, off = wgid / NXCD; wgid = (xcd < r ? xcd * (q + 1) : r * (q + 1) + (xcd - r) * q) + off; }
        const int nig = WGM * nN, gid = wgid / nig, fm = gid * WGM, gsz = (nM - fm) < WGM ? (nM - fm) : WGM;
        u.pm = fm + ((wgid % nig) % gsz); u.pn = (wgid % nig) / gsz; return true;
    }
    __device__ __forceinline__ void a_ready(const Unit&) const {}
    __device__ __forceinline__ void done(const Unit&) const {}
};

__device__ __forceinline__ unsigned cvt_pk_bf16(float lo, float hi) { unsigned r; asm volatile("v_cvt_pk_bf16_f32 %0, %1, %2" : "=v"(r) : "v"(lo), "v"(hi)); return r; }
typedef float f32x2 __attribute__((ext_vector_type(2)));
__device__ __forceinline__ f32x2 gelu_pk(f32x2 v) {
    const f32x2 av = __builtin_elementwise_abs(v), d = av * 0.2316418882f + 1.0f;
    f32x2 t; t.x = __builtin_amdgcn_rcpf(d.x); t.y = __builtin_amdgcn_rcpf(d.y);
    f32x2 q = t * 0.5307027145f + (-0.7265760135f); q = q * t + 0.7107068705f; q = q * t + (-0.142248368f); q = q * t + 0.127414796f; q = q * t;
    const f32x2 s = (v * v) * (-0.72134752044f);
    f32x2 e; e.x = __builtin_amdgcn_exp2f(s.x); e.y = __builtin_amdgcn_exp2f(s.y);
    const f32x2 m = v * (q * e), r = v - m;
    f32x2 o; o.x = v.x < 0.f ? m.x : r.x; o.y = v.y < 0.f ? m.y : r.y; return o;
}

template <int ACT  > struct EpiBf16 {
    static constexpr bool PERM = true, AFTER_DRAIN = false; static_assert(ACT == 0 || ACT == 1, "EpiBf16: ACT is 0 (none) or 1 (gelu_pk)");
    bf16_t* O; int ldc; const float* bias; int split_cols; size_t split_stride; float scale0;
    __device__ __forceinline__ void operator()(const f32x4 (&acc)[2][2][4][2], const Unit& u, int wr, int wc, int fr, int fq) const {
        const int row0 = u.pm * BM + wr * 64 + fr; int colt = u.pn * BM; bf16_t* base = O;
        float sc = 1.f; if (split_cols) { const int t = colt / split_cols; base += (size_t)t * split_stride; colt -= t * split_cols; if (t == 0) sc = scale0; }
        const int col0 = colt + wc * 32 + 8 * fq, bcol0 = u.pn * BM + wc * 32 + 8 * fq;
        f32x4 bv[2][2];
#pragma unroll
        for (int bj = 0; bj < 2; ++bj)
#pragma unroll
            for (int n = 0; n < 2; ++n) bv[bj][n] = bias ? *(const f32x4*)(bias + bcol0 + bj * HALF + 4 * n) : (f32x4){0.f, 0.f, 0.f, 0.f};
#pragma unroll
        for (int ai = 0; ai < 2; ++ai)
#pragma unroll
            for (int m = 0; m < 4; ++m) { bf16_t* rowp = base + (size_t)(row0 + ai * HALF + m * 16) * ldc + col0;
#pragma unroll
                for (int bj = 0; bj < 2; ++bj) { f32x4 v0 = acc[ai][bj][m][0] + bv[bj][0], v1 = acc[ai][bj][m][1] + bv[bj][1];
                    if (ACT == 1) { f32x2 a = gelu_pk((f32x2){v0[0], v0[1]}), b = gelu_pk((f32x2){v0[2], v0[3]}), c = gelu_pk((f32x2){v1[0], v1[1]}), d = gelu_pk((f32x2){v1[2], v1[3]});
                        v0 = (f32x4){a.x, a.y, b.x, b.y}; v1 = (f32x4){c.x, c.y, d.x, d.y}; }
                    v0 = v0 * sc; v1 = v1 * sc; u32x4 w; w.x = cvt_pk_bf16(v0[0], v0[1]); w.y = cvt_pk_bf16(v0[2], v0[3]); w.z = cvt_pk_bf16(v1[0], v1[1]); w.w = cvt_pk_bf16(v1[2], v1[3]);
                    *(u32x4*)(rowp + bj * HALF) = w; } }
    }
};

template <class Sink> struct Epi8 {
    static constexpr bool PERM = true, AFTER_DRAIN = false;
    Sink s;
    __device__ __forceinline__ void operator()(const f32x4 (&acc)[2][2][4][2], const Unit& u, int wr, int wc, int fr, int fq) const {
        const int row0 = u.pm * BM + wr * 64 + fr, col0 = u.pn * BM + wc * 32 + 8 * fq;
#pragma unroll
        for (int ai = 0; ai < 2; ++ai)
#pragma unroll
            for (int m = 0; m < 4; ++m)
#pragma unroll
                for (int bj = 0; bj < 2; ++bj) {
                    const f32x4 a0 = acc[ai][bj][m][0], a1 = acc[ai][bj][m][1];
                    const float v[8] = {a0[0], a0[1], a0[2], a0[3], a1[0], a1[1], a1[2], a1[3]};
                    s(row0 + ai * HALF + m * 16, col0 + bj * HALF, v);
                }
    }
};

template <class Epi, class Sched, bool ALIGN_EPI = false, bool SP2 = false>
__device__ __forceinline__ void gemm_phase(PG8_LAS unsigned char* lds, const Gemm g, const Sched& S, const Epi& E) {
    const int tid = threadIdx.x, wid = __builtin_amdgcn_readfirstlane(tid >> 6), lane = tid & 63, wr = wid >> 2, wc = wid & 3, fr = lane & 15, fq = lane >> 4;
    const int K = g.K, nt = K / BK;
    unsigned voffA[2], voffB[2];
#pragma unroll
    for (int i = 0; i < 2; ++i) { int R, C; stage_rc(tid * 16 + i * 8192, R, C); const int Rb = Epi::PERM ? ((R & ~31) + perm32(R & 31)) : R;
        voffA[i] = (unsigned)(R * K + C) * 2u; voffB[i] = (unsigned)(Rb * K + C) * 2u; }
    const size_t kstep = (size_t)(BK * 2);
    const size_t hstep = (size_t)HALF * K * 2;
    const size_t tstep = 2 * hstep;
    const unsigned ldsw = (unsigned)wid * 1024u;
    const int aoff = lds_byte(wr * 64 + fr, fq * 8), boff = lds_byte(wc * 32 + fr, fq * 8);
#define PG8_SA(b, h) (((b) * 2 + (h)) * HTB)
#define PG8_SB(b, h) ((4 + (b) * 2 + (h)) * HTB)
#define PG8_STAGE(bufoff, gbase, voff) do { _Pragma("unroll") for (int _i = 0; _i < 2; ++_i) \
        __builtin_amdgcn_global_load_lds((const unsigned*)((const char*)(gbase) + (voff)[_i]), (PG8_LAS unsigned*)(lds + (bufoff) + ldsw + _i * 8192), 16, 0, 0); } while (0)
#define PG8_LDA(dst, b, h) do { _Pragma("unroll") for (int m = 0; m < 4; ++m) _Pragma("unroll") for (int k = 0; k < 2; ++k) dst[m][k] = *(const PG8_LAS bf16x8*)(lds + PG8_SA(b, h) + aoff + m * 2048 + k * 1024); } while (0)
#define PG8_LDB(dst, b, h) do { _Pragma("unroll") for (int n = 0; n < 2; ++n) _Pragma("unroll") for (int k = 0; k < 2; ++k) dst[n][k] = *(const PG8_LAS bf16x8*)(lds + PG8_SB(b, h) + boff + n * 2048 + k * 1024); } while (0)
#define PG8_MMA(ai, bj, At, Bt) do { __builtin_amdgcn_s_setprio(1); _Pragma("unroll") for (int m = 0; m < 4; ++m) _Pragma("unroll") for (int n = 0; n < 2; ++n) _Pragma("unroll") for (int k = 0; k < 2; ++k) \
        acc[ai][bj][m][n] = __builtin_amdgcn_mfma_f32_16x16x32_bf16(Bt[n][k], At[m][k], acc[ai][bj][m][n], 0, 0, 0); __builtin_amdgcn_s_setprio(0); } while (0)
#define PG8_WAIT_V(n) asm volatile("s_waitcnt vmcnt(" #n ")" ::: "memory")
#define PG8_WAIT_L(n) asm volatile("s_waitcnt lgkmcnt(" #n ")" ::: "memory")
#define PG8_BAR __builtin_amdgcn_s_barrier()
#define PG8_SCHED __builtin_amdgcn_sched_barrier(0)
    Unit cur, nxt; int ui = 0;
    if (!S.next(0, cur)) return;
    f32x4 acc[2][2][4][2];
#pragma unroll
    for (int a = 0; a < 2; ++a)
#pragma unroll
        for (int b = 0; b < 2; ++b)
#pragma unroll
            for (int m = 0; m < 4; ++m)
#pragma unroll
                for (int n = 0; n < 2; ++n) acc[a][b][m][n] = (f32x4){0.f, 0.f, 0.f, 0.f};
    bf16x8 At[4][2], B0[2][2], B1[2][2];
    const char* cA = (const char*)g.A + (size_t)cur.pm * tstep; const char* cB = (const char*)g.Bt + (size_t)cur.pn * tstep;
    S.a_ready(cur);
    if constexpr (SP2) {
        PG8_STAGE(PG8_SB(0, 0), cB, voffB); PG8_STAGE(PG8_SB(0, 1), cB + hstep, voffB); PG8_STAGE(PG8_SA(0, 0), cA, voffA); PG8_STAGE(PG8_SA(0, 1), cA + hstep, voffA);
        if (wr == 1) PG8_BAR;
        PG8_WAIT_V(2); PG8_BAR;
        PG8_STAGE(PG8_SB(1, 0), cB + kstep, voffB); PG8_STAGE(PG8_SA(1, 0), cA + kstep, voffA); PG8_STAGE(PG8_SB(1, 1), cB + hstep + kstep, voffB);
        PG8_WAIT_V(6); PG8_BAR;
    } else {
        PG8_STAGE(PG8_SB(0, 0), cB, voffB); PG8_STAGE(PG8_SA(0, 0), cA, voffA); PG8_STAGE(PG8_SB(0, 1), cB + hstep, voffB); PG8_STAGE(PG8_SA(0, 1), cA + hstep, voffA);
        if (wr == 1) PG8_BAR;
        PG8_WAIT_V(4); PG8_BAR;
        PG8_STAGE(PG8_SB(1, 0), cB + kstep, voffB); PG8_STAGE(PG8_SA(1, 0), cA + kstep, voffA); PG8_STAGE(PG8_SB(1, 1), cB + hstep + kstep, voffB);
        PG8_WAIT_V(6); PG8_BAR;
    }
    for (;;) {
        const bool has_next = S.next(ui + 1, nxt);
        const char* nA = has_next ? (const char*)g.A + (size_t)nxt.pm * tstep : cA; const char* nB = has_next ? (const char*)g.Bt + (size_t)nxt.pn * tstep : cB;
        for (int t = 0; t < nt; t += 2) {
            const bool last = (t == nt - 2);
            const char* a1 = cA + (size_t)(t + 1) * kstep;
            const char* a2 = last ? nA : cA + (size_t)(t + 2) * kstep; const char* b2 = last ? nB : cB + (size_t)(t + 2) * kstep;
            const char* a3 = a2 + kstep; const char* b3 = b2 + kstep;
            if (last && has_next) S.a_ready(nxt);
            if constexpr (SP2) {
            PG8_LDB(B0, 0, 0); PG8_LDB(B1, 0, 1); PG8_SCHED; PG8_LDA(At, 0, 0); PG8_STAGE(PG8_SA(1, 1), a1 + hstep, voffA);
            PG8_WAIT_V(8); PG8_WAIT_L(0); PG8_BAR; PG8_MMA(0, 0, At, B0); PG8_MMA(0, 1, At, B1); PG8_BAR; PG8_SCHED;
            PG8_LDA(At, 0, 1); PG8_STAGE(PG8_SB(0, 0), b2, voffB); PG8_STAGE(PG8_SB(0, 1), b2 + hstep, voffB); PG8_STAGE(PG8_SA(0, 0), a2, voffA);
            PG8_WAIT_V(8); PG8_WAIT_L(0); PG8_BAR; PG8_MMA(1, 0, At, B0); PG8_MMA(1, 1, At, B1); PG8_BAR; PG8_SCHED;
            PG8_LDB(B0, 1, 0); PG8_LDB(B1, 1, 1); PG8_SCHED; PG8_LDA(At, 1, 0); PG8_STAGE(PG8_SA(0, 1), a2 + hstep, voffA);
            PG8_WAIT_V(8); PG8_WAIT_L(0); PG8_BAR; PG8_MMA(0, 0, At, B0); PG8_MMA(0, 1, At, B1); PG8_BAR; PG8_SCHED;
            PG8_LDA(At, 1, 1); PG8_STAGE(PG8_SB(1, 0), b3, voffB); PG8_STAGE(PG8_SB(1, 1), b3 + hstep, voffB); PG8_STAGE(PG8_SA(1, 0), a3, voffA);
            PG8_WAIT_V(8); PG8_WAIT_L(0); PG8_BAR; PG8_MMA(1, 0, At, B0); PG8_MMA(1, 1, At, B1); PG8_BAR; PG8_SCHED;
            } else {
            PG8_LDB(B0, 0, 0); PG8_SCHED; PG8_LDA(At, 0, 0); PG8_STAGE(PG8_SA(1, 1), a1 + hstep, voffA);
            PG8_WAIT_L(8); PG8_BAR; PG8_WAIT_L(0); PG8_MMA(0, 0, At, B0); PG8_BAR; PG8_SCHED;
            PG8_LDB(B1, 0, 1); PG8_STAGE(PG8_SB(0, 0), b2, voffB);
            PG8_BAR; PG8_WAIT_L(0); PG8_MMA(0, 1, At, B1); PG8_BAR;
            PG8_LDA(At, 0, 1); PG8_STAGE(PG8_SA(0, 0), a2, voffA);
            PG8_BAR; PG8_WAIT_L(0); PG8_MMA(1, 0, At, B0); PG8_BAR; PG8_SCHED;
            PG8_STAGE(PG8_SB(0, 1), b2 + hstep, voffB);
            PG8_WAIT_V(6); PG8_BAR; PG8_MMA(1, 1, At, B1); PG8_BAR;
            PG8_LDB(B0, 1, 0); PG8_SCHED; PG8_LDA(At, 1, 0); PG8_STAGE(PG8_SA(0, 1), a2 + hstep, voffA);
            PG8_WAIT_L(8); PG8_BAR; PG8_WAIT_L(0); PG8_MMA(0, 0, At, B0); PG8_BAR; PG8_SCHED;
            PG8_LDB(B1, 1, 1); PG8_STAGE(PG8_SB(1, 0), b3, voffB);
            PG8_BAR; PG8_WAIT_L(0); PG8_MMA(0, 1, At, B1); PG8_BAR;
            PG8_LDA(At, 1, 1); PG8_STAGE(PG8_SA(1, 0), a3, voffA);
            PG8_BAR; PG8_WAIT_L(0); PG8_MMA(1, 0, At, B0); PG8_BAR; PG8_SCHED;
            PG8_STAGE(PG8_SB(1, 1), b3 + hstep, voffB);
            PG8_WAIT_V(6); PG8_BAR; PG8_MMA(1, 1, At, B1); PG8_BAR;
            }
        }
        if constexpr (ALIGN_EPI) { if (wr == 0) PG8_BAR; }
        if constexpr (!Epi::AFTER_DRAIN) { E(acc, cur, wr, wc, fr, fq); S.done(cur); }
        if (!has_next) break;
#pragma unroll
        for (int a = 0; a < 2; ++a)
#pragma unroll
            for (int b = 0; b < 2; ++b)
#pragma unroll
                for (int m = 0; m < 4; ++m)
#pragma unroll
                    for (int n = 0; n < 2; ++n) acc[a][b][m][n] = (f32x4){0.f, 0.f, 0.f, 0.f};
        cur = nxt; cA = nA; cB = nB; ++ui;
        if constexpr (ALIGN_EPI) { if (wr == 1) PG8_BAR; }
    }
    PG8_WAIT_V(0);
    if constexpr (!ALIGN_EPI) { if (wr == 0) PG8_BAR; }
    PG8_BAR;
    if constexpr (Epi::AFTER_DRAIN) { E.fused(acc, cur, wr, wc, fr, fq, lds, wid, lane); S.done(cur); }
#undef PG8_SA
#undef PG8_SB
#undef PG8_STAGE
#undef PG8_LDA
#undef PG8_LDB
#undef PG8_MMA
#undef PG8_WAIT_V
#undef PG8_WAIT_L
#undef PG8_BAR
#undef PG8_SCHED
}
}

#ifndef PG8_SP2
#define PG8_SP2 true
#endif
#ifndef PG8_ALIGN
#define PG8_ALIGN true
#endif

#define GAS __attribute__((address_space(1)))
#define LAS __attribute__((address_space(3)))
typedef unsigned short bf16;
typedef unsigned v4u __attribute__((ext_vector_type(4)));
typedef float f32x4 __attribute__((ext_vector_type(4)));
typedef short bf16x8 __attribute__((ext_vector_type(8)));
typedef GAS unsigned gu32;
typedef GAS unsigned long long gu64;
#define RLX_AGENT __ATOMIC_RELAXED, __HIP_MEMORY_SCOPE_AGENT
#define LDS_WAIT() asm volatile("s_waitcnt lgkmcnt(0)" ::: "memory")
#define VM_WAIT() asm volatile("s_waitcnt vmcnt(0)" ::: "memory")
__device__ __forceinline__ unsigned long long rt() { return __builtin_amdgcn_s_memrealtime(); }
__device__ __forceinline__ unsigned f2bf(float f) { unsigned u = __builtin_bit_cast(unsigned, f); return (u + 0x7fffu + ((u >> 16) & 1u)) >> 16; }
__device__ __forceinline__ unsigned pk2(float lo, float hi) { return f2bf(lo) | (f2bf(hi) << 16); }

#define XB_TMO      128
#define XB_XCNT(j)  (256  + 64 * (j))
#define XB_XSUB(j)  (1280 + 64 * (j))
#define XB_XGEN(j)  (2304 + 64 * (j))
#define XB_TOP      3328
#define XB_TOPGEN   3392
#define XCD_BAR_WORDS 3456
#define XB_SPIN_CAP (1u << 18)

__device__ __forceinline__ unsigned xb_ld(unsigned* p)              { return __hip_atomic_load(p, __ATOMIC_RELAXED, __HIP_MEMORY_SCOPE_AGENT); }
__device__ __forceinline__ unsigned xb_add(unsigned* p, unsigned v) { return __hip_atomic_fetch_add(p, v, __ATOMIC_RELAXED, __HIP_MEMORY_SCOPE_AGENT); }
__device__ __forceinline__ unsigned xb_xcc_id() { return (unsigned)__builtin_amdgcn_s_getreg((3 << 11) | 20) & 0xFu; }
#define XB_SPIN(cond, bar) do { unsigned _sp = 0; while (cond) { __builtin_amdgcn_s_sleep(1); \
    if ((++_sp & 255u) == 0u) { if (xb_ld(&(bar)[XB_TMO])) break; if (_sp > XB_SPIN_CAP) { atomicAdd(&(bar)[XB_TMO], 1u); break; } } } } while (0)

struct XcdBarrier {
    unsigned* bar; unsigned x;
    volatile LAS unsigned* st;
};

__device__ __forceinline__ XcdBarrier xcd_barrier_post(unsigned* bar, volatile LAS unsigned* st) {
    XcdBarrier b; b.bar = bar; b.x = xb_xcc_id(); b.st = st;
    if (threadIdx.x == 0) (void)xb_add(&bar[XB_XCNT(b.x)], 1u);
    return b;
}
__device__ __forceinline__ void xcd_barrier_complete(unsigned* bar, unsigned x, unsigned& nloc, unsigned& nx) {
    const unsigned G = gridDim.x * gridDim.y * gridDim.z;
    unsigned sum, cnt, mine, sp = 0u;
    for (;;) {
        sum = 0u; cnt = 0u; mine = 0u;
#pragma unroll
        for (unsigned j = 0; j < 16; ++j) { const unsigned c = xb_ld(&bar[XB_XCNT(j)]); sum += c; cnt += (c > 0u) ? 1u : 0u; mine = (j == x) ? c : mine; }
        if (sum == G) break;
        __builtin_amdgcn_s_sleep(1);
        if ((++sp & 255u) == 0u) { if (xb_ld(&bar[XB_TMO])) break; if (sp > XB_SPIN_CAP) { atomicAdd(&bar[XB_TMO], 1u); break; } }
    }
    nloc = mine > 0u ? mine : 1u; nx = cnt > 0u ? cnt : 1u;
}

__device__ __forceinline__ void xcd_barrier(const XcdBarrier& b) {
    asm volatile("s_waitcnt vmcnt(0)" ::: "memory");
    __syncthreads();
    if (threadIdx.x == 0) {
        unsigned* bar = b.bar;
        __builtin_amdgcn_s_waitcnt(0);
        unsigned nloc = b.st[0], nx = b.st[1];
        if (nloc == 0u) { xcd_barrier_complete(bar, b.x, nloc, nx); b.st[0] = nloc; b.st[1] = nx; }
        const unsigned old = xb_add(&bar[XB_XSUB(b.x)], 1u);
        const unsigned gen = old / nloc;
        if (old + 1u == (gen + 1u) * nloc) {
            __builtin_amdgcn_fence(__ATOMIC_RELEASE, "agent");
            asm volatile("s_waitcnt vmcnt(0)" ::: "memory");
            const unsigned og = xb_add(&bar[XB_TOP], 1u);
            const unsigned tg = og / nx;
            if (og + 1u == (tg + 1u) * nx) xb_add(&bar[XB_TOPGEN], 1u);
            else XB_SPIN(xb_ld(&bar[XB_TOPGEN]) == tg, bar);
            __builtin_amdgcn_fence(__ATOMIC_ACQUIRE, "agent");
            xb_add(&bar[XB_XGEN(b.x)], 1u);
            asm volatile("s_waitcnt vmcnt(0)" ::: "memory");
        } else {
            XB_SPIN(xb_ld(&bar[XB_XGEN(b.x)]) == gen, bar);
            __builtin_amdgcn_fence(__ATOMIC_ACQUIRE, "agent");
            asm volatile("s_waitcnt vmcnt(0)" ::: "memory");
        }
    }
    __syncthreads();
}

constexpr int NWAVES = 8, NTHR = 512;
constexpr int DM = 2048, NTOK = 8192, SEQ = 4096;
constexpr int DS5 = 1024, NGRP = 64, GH = 16, NST = 64;
constexpr int NHEAD = 4, GDK = 512, GDV = 1024, HK = 128, HV = 256, RANK = 16, CHUNK = 64, NCHUNK = 64;
constexpr int DIN = 5136, DINP = 5376;
constexpr float EPS = 1e-6f;
enum { I_X = 0, I_PREW, I_WIN, I_ARE, I_AIM, I_BRE, I_BIM, I_CRE, I_CIM, I_D, I_LOGDT, I_GLUW, I_GLUB, I_GUP, I_GBIAS, I_GNORM, I_WOUT, I_POSTW, N_IN };

constexpr size_t MiB = 1u << 20;
constexpr size_t WS_CTL = 0, CTL_ZERO_BYTES = 65536;
constexpr size_t WS_WIN = 1 * MiB;
constexpr size_t WS_WGLU = 22 * MiB;
constexpr size_t WS_WOUT = 24 * MiB;
constexpr size_t WS_XN = 32 * MiB;
constexpr size_t WS_KVT = 32 * MiB;
constexpr size_t WS_CONCAT = 32 * MiB;
constexpr size_t WS_UT = 64 * MiB;
constexpr size_t WS_ZS5 = 80 * MiB;
constexpr size_t WS_MIXED = 64 * MiB;
constexpr size_t WS_Q = 96 * MiB;
constexpr size_t WS_K = 104 * MiB;
constexpr size_t WS_V = 112 * MiB;
constexpr size_t WS_ZGLA = 128 * MiB;
constexpr size_t WS_GLOW = 144 * MiB;
constexpr size_t WS_DEC = 145 * MiB;
constexpr size_t WS_SPV = 146 * MiB;
constexpr size_t WS_KT = 150 * MiB;
constexpr size_t WS_AT = 153 * MiB;
constexpr size_t WS_W1 = 154 * MiB;
constexpr size_t WS_W2 = 170 * MiB;
constexpr size_t WS_YPRE = 186 * MiB;
constexpr size_t WS_SPT = 202 * MiB;
constexpr size_t WS_QE = 234 * MiB;
constexpr size_t WS_KE = 242 * MiB;
constexpr size_t WS_END = 250 * MiB;
constexpr int CW_BAR = 4096;

constexpr int RING_OFF = 0, RING_BYTES = 131072;
constexpr int LDSCTL_OFF = RING_BYTES, MISC_OFF = LDSCTL_OFF + 320;
constexpr int LDS_BYTES = 147456;

struct Args { const float* in[N_IN]; float* out; unsigned char* ws; int ph_lo, ph_hi; };
static_assert(sizeof(Args) == N_IN * 8 + 8 + 8 + 8, "Args has no padding");

struct Frame {
    LAS unsigned char* lds; volatile LAS unsigned* MISC; gu32* ctl;
    int tid, lane, wave, vcu, G;
};

__device__ __forceinline__ float wave_sum(float v) {
#pragma unroll
    for (int o = 1; o < 64; o <<= 1) v += __shfl_xor(v, o);
    return v;
}
__device__ __forceinline__ float bf2f(unsigned short b) { return __builtin_bit_cast(float, ((unsigned)b) << 16); }
__device__ __forceinline__ void store8bf(bf16* p, const float (&v)[8]) {
    v4u w; w.x = pg8::cvt_pk_bf16(v[0], v[1]); w.y = pg8::cvt_pk_bf16(v[2], v[3]); w.z = pg8::cvt_pk_bf16(v[4], v[5]); w.w = pg8::cvt_pk_bf16(v[6], v[7]);
    *(v4u*)p = w;
}
__device__ __forceinline__ void load8bf(const bf16* p, float (&v)[8]) {
    const v4u w = *(const v4u*)p;
    v[0] = __builtin_bit_cast(float, w.x << 16); v[1] = __builtin_bit_cast(float, w.x & 0xffff0000u);
    v[2] = __builtin_bit_cast(float, w.y << 16); v[3] = __builtin_bit_cast(float, w.y & 0xffff0000u);
    v[4] = __builtin_bit_cast(float, w.z << 16); v[5] = __builtin_bit_cast(float, w.z & 0xffff0000u);
    v[6] = __builtin_bit_cast(float, w.w << 16); v[7] = __builtin_bit_cast(float, w.w & 0xffff0000u);
}
__device__ __forceinline__ float sigmoidf_(float x) { return 1.0f / (1.0f + __expf(-x)); }
__device__ __forceinline__ float siluf_(float x) { return x * sigmoidf_(x); }
__device__ __forceinline__ float gelu_tanh(float x) {
    const float z = 0.7978845608028654f * (x + 0.044715f * x * x * x);
    const float t = 1.0f - 2.0f / (1.0f + __expf(2.0f * z));
    return 0.5f * x * (1.0f + t);
}
__device__ __forceinline__ float log_sigmoid(float z) { return fminf(z, 0.f) - log1pf(__expf(-fabsf(z))); }
__device__ __forceinline__ void cexp_dt(float ar, float ai, float dt, float mult, float& re, float& im) {
    const double th = (double)ai * (double)dt * (double)mult;
    const double k = __builtin_rint(th * 0.15915494309189535);
    const float r = (float)(th - k * 6.283185307179586);
    const float mag = expf(ar * dt * mult);
    re = mag * cosf(r); im = mag * sinf(r);
}

struct ProjSink {
    bf16 *UT, *ZS5, *Q, *K, *V, *ZGLA; float* GLOW;
    __device__ __forceinline__ void operator()(int row, int c0, const float (&v)[8]) const {
        if (c0 < 1024) { const int g = c0 >> 4; store8bf(UT + ((size_t)g * NTOK + row) * 16 + (c0 & 15), v); }
        else if (c0 < 2048) { float o[8];
#pragma unroll
            for (int i = 0; i < 8; ++i) o[i] = siluf_(v[i]);
            store8bf(ZS5 + (size_t)row * 1024 + (c0 - 1024), o); }
        else if (c0 < 2560) { float o[8];
#pragma unroll
            for (int i = 0; i < 8; ++i) o[i] = v[i] * 0.08838834764831845f;
            store8bf(Q + (size_t)row * 512 + (c0 - 2048), o); }
        else if (c0 < 3072) store8bf(K + (size_t)row * 512 + (c0 - 2560), v);
        else if (c0 < 4096) store8bf(V + (size_t)row * 1024 + (c0 - 3072), v);
        else if (c0 < 5120) { float o[8];
#pragma unroll
            for (int i = 0; i < 8; ++i) o[i] = siluf_(v[i]);
            store8bf(ZGLA + (size_t)row * 1024 + (c0 - 4096), o); }
        else if (c0 < DIN) { float* p = GLOW + (size_t)row * 16 + (c0 - 5120);
            *(f32x4*)p = (f32x4){v[0], v[1], v[2], v[3]}; *(f32x4*)(p + 4) = (f32x4){v[4], v[5], v[6], v[7]}; }
    }
};
struct GluSink {
    const bf16 *YPRE, *ZS5; const float* glub; bf16* CONCAT;
    __device__ __forceinline__ void operator()(int row, int c0, const float (&v)[8]) const {
        float y[8], g[8], o[8]; load8bf(YPRE + (size_t)row * 1024 + c0, y); load8bf(ZS5 + (size_t)row * 1024 + c0, g);
        const f32x4 b0 = *(const f32x4*)(glub + c0), b1 = *(const f32x4*)(glub + c0 + 4);
        const float b[8] = {b0[0], b0[1], b0[2], b0[3], b1[0], b1[1], b1[2], b1[3]};
#pragma unroll
        for (int i = 0; i < 8; ++i) o[i] = y[i] * sigmoidf_(v[i] + b[i]) * g[i];
        store8bf(CONCAT + (size_t)row * 2048 + c0, o);
    }
};
struct MixSink {
    bf16* MIXED;
    __device__ __forceinline__ void operator()(int row, int c0, const float (&v)[8]) const { store8bf(MIXED + (size_t)row * 2048 + c0, v); }
};

template <class Sink> __device__ __forceinline__ void naive_gemm(const bf16* A, const bf16* Bt, int M, int N, int K, const Sink& s, int gtid, int gthreads) {
    const int n8 = N / 8; const long total = (long)M * n8;
    for (long it = gtid; it < total; it += gthreads) {
        const int c0 = (int)(it % n8) * 8, row = (int)(it / n8);
        float acc[8] = {0.f, 0.f, 0.f, 0.f, 0.f, 0.f, 0.f, 0.f};
        for (int k = 0; k < K; k += 8) {
            float a[8]; load8bf(A + (size_t)row * K + k, a);
#pragma unroll
            for (int i = 0; i < 8; ++i) { float b[8]; load8bf(Bt + (size_t)(c0 + i) * K + k, b);
#pragma unroll
                for (int j = 0; j < 8; ++j) acc[i] += a[j] * b[j]; }
        }
        s(row, c0, acc);
    }
}

__device__ __forceinline__ void p0_transpose_item(const float* W, int K, int N, int Npad, bf16* WT, LAS float* scr, int item, int lane) {
    const int nblk = Npad / 32, kb = item / nblk, nb = item % nblk, k0 = 64 * kb, n0 = 32 * nb;
    const int nl = n0 + (lane & 31); const bool ok = nl < N;
    float tv[32];
#pragma unroll
    for (int i = 0; i < 32; ++i) { const int kk = 2 * i + (lane >> 5); tv[i] = ok ? W[(size_t)(k0 + kk) * N + nl] : 0.f; }
#pragma unroll
    for (int i = 0; i < 32; ++i) { const int kk = 2 * i + (lane >> 5); scr[kk * 33 + (lane & 31)] = tv[i]; }
    LDS_WAIT(); asm volatile("" ::: "memory");
    const int c = lane & 7;
#pragma unroll
    for (int j = 0; j < 4; ++j) { const int n = (lane >> 3) + 8 * j; const LAS float* s = scr + (8 * c) * 33 + n;
        v4u o; o.x = pg8::cvt_pk_bf16(s[0 * 33], s[1 * 33]); o.y = pg8::cvt_pk_bf16(s[2 * 33], s[3 * 33]); o.z = pg8::cvt_pk_bf16(s[4 * 33], s[5 * 33]); o.w = pg8::cvt_pk_bf16(s[6 * 33], s[7 * 33]);
        *(v4u*)(WT + (size_t)(n0 + n) * K + k0 + 8 * c) = o; }
    LDS_WAIT(); asm volatile("" ::: "memory");
}
__device__ __forceinline__ void p0_xn_rows(const float* x, const float* w, bf16* xn, int m0, int mstride, int lane) {
    const f32x4* wr = (const f32x4*)w + lane; f32x4 wv[8];
#pragma unroll
    for (int j = 0; j < 8; ++j) wv[j] = wr[64 * j];
    for (int m = m0; m < NTOK; m += mstride) {
        const f32x4* xr = (const f32x4*)(x + (size_t)m * DM) + lane;
        f32x4 v[8]; float s = 0.f;
#pragma unroll
        for (int j = 0; j < 8; ++j) v[j] = xr[64 * j];
#pragma unroll
        for (int j = 0; j < 8; ++j) s += (v[j].x * v[j].x + v[j].y * v[j].y) + (v[j].z * v[j].z + v[j].w * v[j].w);
        const float rstd = 1.0f / sqrtf(wave_sum(s) * (1.0f / DM) + EPS);
        unsigned long long* o8 = (unsigned long long*)(xn + (size_t)m * DM) + lane;
#pragma unroll
        for (int j = 0; j < 8; ++j) { const f32x4 o = v[j] * rstd * wv[j];
            o8[64 * j] = (unsigned long long)pg8::cvt_pk_bf16(o.x, o.y) | ((unsigned long long)pg8::cvt_pk_bf16(o.z, o.w) << 32); }
    }
}
constexpr int I_IN = (DM / 64) * (DINP / 32), I_GLU = (DS5 / 64) * (DS5 / 32), I_OUT = (DM / 64) * (DM / 32);
__device__ __forceinline__ void p0_prologue(const Frame& F, const Args& a) {
    LAS float* scr = (LAS float*)(F.lds + RING_OFF + F.wave * 16384);
    const int gw = F.vcu * NWAVES + F.wave, NGW = F.G * NWAVES;
    for (int it = gw; it < I_IN; it += NGW) p0_transpose_item(a.in[I_WIN], DM, DIN, DINP, (bf16*)(a.ws + WS_WIN), scr, it, F.lane);
    p0_xn_rows(a.in[I_X], a.in[I_PREW], (bf16*)(a.ws + WS_XN), gw, NGW, F.lane);
}
__device__ __forceinline__ void late_transposes(const Frame& F, const Args& a, int w0, int nw) {
    LAS float* scr = (LAS float*)(F.lds + RING_OFF + F.wave * 16384);
    for (int it = w0; it < I_GLU + I_OUT; it += nw) {
        if (it < I_GLU) p0_transpose_item(a.in[I_GLUW], DS5, DS5, DS5, (bf16*)(a.ws + WS_WGLU), scr, it, F.lane);
        else p0_transpose_item(a.in[I_WOUT], DM, DM, DM, (bf16*)(a.ws + WS_WOUT), scr, it - I_GLU, F.lane);
    }
}

__device__ __forceinline__ void s5_naive_item(const Args& a, int item, int lane) {
    const int b = item / NGRP, g = item % NGRP, p = lane;
    const float ar = fminf(a.in[I_ARE][g * NST + p], -1e-4f), ai = a.in[I_AIM][g * NST + p];
    const float dt = expf(a.in[I_LOGDT][g]);
    float abr, abi; cexp_dt(ar, ai, dt, 1.0f, abr, abi);
    const float xr = abr - 1.0f, xi = abi, den = 1.0f / (ar * ar + ai * ai);
    const float cr = (xr * ar + xi * ai) * den, ci = (xi * ar - xr * ai) * den;
    float Bbr[GH], Bbi[GH], Ccr[GH], Cci[GH], Dv[GH];
#pragma unroll
    for (int h = 0; h < GH; ++h) {
        const float br = a.in[I_BRE][(g * NST + p) * GH + h], bi = a.in[I_BIM][(g * NST + p) * GH + h];
        Bbr[h] = cr * br - ci * bi; Bbi[h] = cr * bi + ci * br;
        Ccr[h] = a.in[I_CRE][(g * GH + h) * NST + p]; Cci[h] = a.in[I_CIM][(g * GH + h) * NST + p];
        Dv[h] = a.in[I_D][g * GH + h];
    }
    const bf16* U = (const bf16*)(a.ws + WS_UT) + ((size_t)g * NTOK + (size_t)b * SEQ) * 16;
    bf16* Y = (bf16*)(a.ws + WS_YPRE) + (size_t)b * SEQ * DS5 + g * GH;
    float sr = 0.f, si = 0.f;
    for (int t = 0; t < SEQ; ++t) {
        float u[16]; { float u0[8], u1[8]; load8bf(U + (size_t)t * 16, u0); load8bf(U + (size_t)t * 16 + 8, u1);
#pragma unroll
            for (int i = 0; i < 8; ++i) { u[i] = u0[i]; u[8 + i] = u1[i]; } }
        float bur = 0.f, bui = 0.f;
#pragma unroll
        for (int h = 0; h < GH; ++h) { bur += Bbr[h] * u[h]; bui += Bbi[h] * u[h]; }
        const float nr = abr * sr - abi * si + bur, ni = abr * si + abi * sr + bui; sr = nr; si = ni;
        float mine = 0.f;
#pragma unroll
        for (int h = 0; h < GH; ++h) { const float y = wave_sum(Ccr[h] * sr - Cci[h] * si) + Dv[h] * u[h]; mine = (lane == h) ? y : mine; }
        if (lane < GH) { const float o = gelu_tanh(mine); Y[(size_t)t * DS5 + lane] = (bf16)(pg8::cvt_pk_bf16(o, 0.f) & 0xffffu); }
    }
}

__device__ __forceinline__ void gla_naive_item(const Frame& F, const Args& a, int item) {
    const int b = item / NHEAD, h = item % NHEAD, tid = F.tid, dv = tid & 255, half = tid >> 8;
    LAS float* qs = (LAS float*)(F.lds + RING_OFF); LAS float* ks = qs + 128; LAS float* gs = ks + 128; LAS float* part = gs + 128; LAS float* red = part + 512;
    float S[64];
#pragma unroll
    for (int j = 0; j < 64; ++j) S[j] = 0.f;
    float gu[RANK]; float gb = 0.f;
    if (tid < HK) {
#pragma unroll
        for (int r = 0; r < RANK; ++r) gu[r] = a.in[I_GUP][r * GDK + h * HK + tid];
        gb = a.in[I_GBIAS][h * HK + tid];
    } else {
#pragma unroll
        for (int r = 0; r < RANK; ++r) gu[r] = 0.f;
    }
    const float nw = a.in[I_GNORM][dv];
    const bf16* Q = (const bf16*)(a.ws + WS_Q); const bf16* K = (const bf16*)(a.ws + WS_K); const bf16* V = (const bf16*)(a.ws + WS_V);
    const bf16* ZG = (const bf16*)(a.ws + WS_ZGLA); const float* GL = (const float*)(a.ws + WS_GLOW); bf16* CC = (bf16*)(a.ws + WS_CONCAT);
    for (int t = 0; t < SEQ; ++t) {
        const size_t tok = (size_t)b * SEQ + t;
        if (tid < HK) {
            float z = gb;
#pragma unroll
            for (int r = 0; r < RANK; ++r) z += GL[tok * 16 + r] * gu[r];
            gs[tid] = __expf(log_sigmoid(z) * (1.0f / 16.0f));
            qs[tid] = bf2f(Q[tok * GDK + h * HK + tid]); ks[tid] = bf2f(K[tok * GDK + h * HK + tid]);
        }
        __syncthreads();
        const float v = bf2f(V[tok * GDV + h * HV + dv]);
        float o = 0.f;
#pragma unroll
        for (int j = 0; j < 64; ++j) { const int dk = half * 64 + j; S[j] = gs[dk] * S[j] + ks[dk] * v; o += qs[dk] * S[j]; }
        part[tid] = o;
        __syncthreads();
        float ot = 0.f;
        if (half == 0) { ot = part[dv] + part[256 + dv]; const float ss = wave_sum(ot * ot); if (F.lane == 0) red[F.wave] = ss; }
        __syncthreads();
        if (half == 0) { const float tot = (red[0] + red[1]) + (red[2] + red[3]); const float rstd = 1.0f / sqrtf(tot * (1.0f / HV) + EPS);
            const float res = ot * rstd * nw * bf2f(ZG[tok * GDV + h * HV + dv]);
            CC[tok * 2048 + 1024 + h * HV + dv] = (bf16)(pg8::cvt_pk_bf16(res, 0.f) & 0xffffu); }
        __syncthreads();
    }
}

__device__ __forceinline__ void p6_rows(const float* x, const bf16* mixed, const float* pw, float* out, int m0, int mstride, int lane) {
    f32x4 wv[4][2];
#pragma unroll
    for (int j = 0; j < 4; ++j) { const int c = (lane + 64 * j) * 8; wv[j][0] = *(const f32x4*)(pw + c); wv[j][1] = *(const f32x4*)(pw + c + 4); }
    for (int m = m0; m < NTOK; m += mstride) {
        const float* xrow = x + (size_t)m * DM; const bf16* mrow = mixed + (size_t)m * DM; float* orow = out + (size_t)m * DM;
        float mm[4][8]; f32x4 xv[4][2]; float s = 0.f;
#pragma unroll
        for (int j = 0; j < 4; ++j) { const int c = (lane + 64 * j) * 8; load8bf(mrow + c, mm[j]); xv[j][0] = *(const f32x4*)(xrow + c); xv[j][1] = *(const f32x4*)(xrow + c + 4); }
#pragma unroll
        for (int j = 0; j < 4; ++j)
#pragma unroll
            for (int i = 0; i < 8; ++i) s += mm[j][i] * mm[j][i];
        const float rstd = 1.0f / sqrtf(wave_sum(s) * (1.0f / DM) + EPS);
#pragma unroll
        for (int j = 0; j < 4; ++j) { const int c = (lane + 64 * j) * 8;
#pragma unroll
            for (int q = 0; q < 2; ++q) { const f32x4 mv = (f32x4){mm[j][4 * q], mm[j][4 * q + 1], mm[j][4 * q + 2], mm[j][4 * q + 3]};
                *(f32x4*)(orow + c + 4 * q) = xv[j][q] + mv * rstd * wv[j][q]; } }
    }
}

typedef float f32x16 __attribute__((ext_vector_type(16)));
#define MFMA32(a, b, c) __builtin_amdgcn_mfma_f32_32x32x16_bf16((a), (b), (c), 0, 0, 0)
__device__ __forceinline__ f32x16 zero16() { f32x16 z;
#pragma unroll
    for (int i = 0; i < 16; ++i) z[i] = 0.f;
    return z; }
__device__ __forceinline__ bf16x8 pack_step(const f32x16& x, int s) {
    v4u p;
    asm volatile("s_nop 11\n\tv_cvt_pk_bf16_f32 %0, %4, %5\n\tv_cvt_pk_bf16_f32 %1, %6, %7\n\tv_cvt_pk_bf16_f32 %2, %8, %9\n\tv_cvt_pk_bf16_f32 %3, %10, %11\n\ts_nop 1"
                 : "=&v"(p[0]), "=&v"(p[1]), "=&v"(p[2]), "=&v"(p[3])
                 : "v"(x[8 * s]), "v"(x[8 * s + 1]), "v"(x[8 * s + 2]), "v"(x[8 * s + 3]), "v"(x[8 * s + 4]), "v"(x[8 * s + 5]), "v"(x[8 * s + 6]), "v"(x[8 * s + 7]));
    return __builtin_bit_cast(bf16x8, p);
}
__device__ __forceinline__ bf16x8 pack8(const float (&x)[8]) {
    v4u p;
    asm volatile("v_cvt_pk_bf16_f32 %0, %4, %5\n\tv_cvt_pk_bf16_f32 %1, %6, %7\n\tv_cvt_pk_bf16_f32 %2, %8, %9\n\tv_cvt_pk_bf16_f32 %3, %10, %11\n\ts_nop 1"
                 : "=&v"(p[0]), "=&v"(p[1]), "=&v"(p[2]), "=&v"(p[3])
                 : "v"(x[0]), "v"(x[1]), "v"(x[2]), "v"(x[3]), "v"(x[4]), "v"(x[5]), "v"(x[6]), "v"(x[7]));
    return __builtin_bit_cast(bf16x8, p);
}
__device__ __forceinline__ unsigned short f2bf16(float f) { return (unsigned short)f2bf(f); }

__device__ __forceinline__ void s5_tables(const Frame& F, const Args& a, int g) {
    LAS float* APr = (LAS float*)(F.lds + RING_OFF); LAS float* APi = APr + 64 * 65;
    LAS float* BBr = APi + 64 * 65; LAS float* BBi = BBr + 1024; LAS float* CCr = BBi + 1024; LAS float* CCi = CCr + 1024; LAS float* P2r = CCi + 1024; LAS float* P2i = P2r + 448;
    const int tid = F.tid;
    const float dt = expf(a.in[I_LOGDT][g]);
    if (tid < 64) {
        const int p = tid;
        const float ar = fminf(a.in[I_ARE][g * NST + p], -1e-4f), ai = a.in[I_AIM][g * NST + p];
        float abr, abi; cexp_dt(ar, ai, dt, 1.0f, abr, abi);
        const float xr = abr - 1.0f, xi = abi, den = 1.0f / (ar * ar + ai * ai);
        const float cr = (xr * ar + xi * ai) * den, ci = (xi * ar - xr * ai) * den;
#pragma unroll
        for (int h = 0; h < GH; ++h) { const float br = a.in[I_BRE][(g * NST + p) * GH + h], bi = a.in[I_BIM][(g * NST + p) * GH + h];
            BBr[p * 16 + h] = cr * br - ci * bi; BBi[p * 16 + h] = cr * bi + ci * br; }
        float qr = abr, qi = abi;
#pragma unroll
        for (int k = 0; k < 7; ++k) { P2r[k * 64 + p] = qr; P2i[k * 64 + p] = qi; const float nr = qr * qr - qi * qi, ni = 2.f * qr * qi; qr = nr; qi = ni; }
    }
    for (int i = tid; i < 1024; i += NTHR) { CCr[i] = a.in[I_CRE][g * 1024 + i]; CCi[i] = a.in[I_CIM][g * 1024 + i]; }
    __syncthreads();
    for (int i = tid; i < 64 * 65; i += NTHR) { const int p = i / 65, d = i - p * 65;
        float r = 1.f, im = 0.f;
#pragma unroll
        for (int k = 0; k < 7; ++k) if ((d >> k) & 1) { const float qr = P2r[k * 64 + p], qi = P2i[k * 64 + p]; const float nr = r * qr - im * qi, ni = r * qi + im * qr; r = nr; im = ni; }
        APr[i] = r; APi[i] = im; }
    __syncthreads();
#pragma unroll 1
    for (int qt = 0; qt < 4; ++qt) {
    { bf16* W2 = (bf16*)(a.ws + WS_W2) + (size_t)g * 1024 * 128;
      for (int it = tid; it < 256 * 16; it += NTHR) { const int row = qt * 256 + (it >> 4), cg = it & 15, t = row >> 4, h = row & 15, ri = cg >> 3, p0 = (cg & 7) * 8;
        float o[8];
#pragma unroll
        for (int e = 0; e < 8; ++e) { const int p = p0 + e; const float cr = CCr[h * 64 + p], ci = CCi[h * 64 + p], pr = APr[p * 65 + t + 1], pi = APi[p * 65 + t + 1];
            o[e] = ri == 0 ? (cr * pr - ci * pi) : -(cr * pi + ci * pr); }
        store8bf(W2 + (size_t)row * 128 + cg * 8, o); } }
    { bf16* W1 = (bf16*)(a.ws + WS_W1) + (size_t)g * 128 * 1024;
      for (int it = tid; it < 32 * 64; it += NTHR) { const int row = qt * 32 + (it >> 6), j = it & 63, p = row & 63, ri = row >> 6;
        const float pr = APr[p * 65 + 63 - j], pi = APi[p * 65 + 63 - j];
        float o0[8], o1[8];
#pragma unroll
        for (int e = 0; e < 8; ++e) { const float b0r = BBr[p * 16 + e], b0i = BBi[p * 16 + e], b1r = BBr[p * 16 + 8 + e], b1i = BBi[p * 16 + 8 + e];
            o0[e] = ri == 0 ? (pr * b0r - pi * b0i) : (pr * b0i + pi * b0r); o1[e] = ri == 0 ? (pr * b1r - pi * b1i) : (pr * b1i + pi * b1r); }
        store8bf(W1 + (size_t)row * 1024 + j * 16, o0); store8bf(W1 + (size_t)row * 1024 + j * 16 + 8, o1); } }
    }
    { bf16* KT = (bf16*)(a.ws + WS_KT) + (size_t)g * 65 * 256;
      const int lane = F.lane, r = lane & 31, hf = lane >> 5, w = F.wave;
      bf16x8 bfr[8];
#pragma unroll
      for (int ks = 0; ks < 8; ++ks) { float x[8];
#pragma unroll
          for (int e = 0; e < 8; ++e) { const int p = 16 * (ks & 3) + 8 * hf + e; x[e] = (r < 16) ? ((ks >> 2) ? BBi[p * 16 + r] : BBr[p * 16 + r]) : 0.f; }
          bfr[ks] = pack8(x); }
#pragma unroll 1
      for (int ti = 0; ti < 4; ++ti) { const int tile = w + 8 * ti, d = 2 * tile + (r >> 4), h = r & 15;
          f32x16 acc = zero16();
#pragma unroll
          for (int kp = 0; kp < 4; ++kp) { float gre[8], gim[8];
#pragma unroll
              for (int e = 0; e < 8; ++e) { const int p = 16 * kp + 8 * hf + e; const float cr = CCr[h * 64 + p], ci = CCi[h * 64 + p], pr = APr[p * 65 + d], pi = APi[p * 65 + d];
                  gre[e] = cr * pr - ci * pi; gim[e] = -(cr * pi + ci * pr); }
              acc = MFMA32(pack8(gre), bfr[kp], acc); acc = MFMA32(pack8(gim), bfr[4 + kp], acc); }
          if (r < 16) {
#pragma unroll
              for (int rr = 0; rr < 16; ++rr) { const int rl = (rr & 3) + 8 * (rr >> 2) + 4 * hf, dd = 2 * tile + (rl >> 4), hh = rl & 15; KT[(size_t)(dd + 1) * 256 + hh * 16 + r] = f2bf16(acc[rr]); } } }
      if (tid < 32) { const float z[8] = {0.f, 0.f, 0.f, 0.f, 0.f, 0.f, 0.f, 0.f}; store8bf(KT + tid * 8, z); } }
    if (tid < 64) { float* AT = (float*)(a.ws + WS_AT) + (size_t)(g * 64 + tid) * 2; AT[0] = APr[tid * 65 + 64]; AT[1] = APi[tid * 65 + 64]; }
    __syncthreads();
}

__device__ __forceinline__ void s5_sloc_item(const Frame& F, const Args& a, int item) {
    const int g = item >> 1, b = item & 1, w = F.wave, mt = w >> 1, nt = w & 1, lane = F.lane, r = lane & 31, hf = lane >> 5;
    const bf16* U = (const bf16*)(a.ws + WS_UT) + ((size_t)g * NTOK + (size_t)b * SEQ + (size_t)(nt * 32 + r) * 64) * 16 + 8 * hf;
    const bf16* W1 = (const bf16*)(a.ws + WS_W1) + ((size_t)g * 128 + mt * 32 + r) * 1024 + 8 * hf;
    f32x16 acc = zero16();
#pragma unroll 8
    for (int ks = 0; ks < 64; ++ks) {
        const bf16x8 av = *(const bf16x8*)(U + ks * 16), bv = *(const bf16x8*)(W1 + ks * 16);
        acc = MFMA32(av, bv, acc);
    }
    LAS float* SLL = (LAS float*)(F.lds + RING_OFF);
#pragma unroll
    for (int rr = 0; rr < 16; ++rr) { const int nl = (rr & 3) + 8 * (rr >> 2) + 4 * hf; SLL[(nt * 32 + nl) * 128 + mt * 32 + r] = acc[rr]; }
    __syncthreads();
    if (w == 0) {
        const float* AT = (const float*)(a.ws + WS_AT) + (size_t)(g * 64 + lane) * 2; const float atr = AT[0], ati = AT[1];
        unsigned short* SPV = (unsigned short*)(a.ws + WS_SPV) + ((size_t)g * 128 + b * 64) * 128;
        float sr = 0.f, si = 0.f;
#pragma unroll 4
        for (int c = 0; c < 64; ++c) {
            SPV[(size_t)c * 128 + lane] = f2bf16(sr); SPV[(size_t)c * 128 + 64 + lane] = f2bf16(si);
            const float lr = SLL[c * 128 + lane], li = SLL[c * 128 + 64 + lane];
            const float nr = atr * sr - ati * si + lr, ni = atr * si + ati * sr + li; sr = nr; si = ni; }
    }
    __syncthreads();
}

constexpr int S5_KTL = 0, S5_UL = 33280, S5_ULROW = 2064, S5_SPL = S5_UL + 32 * S5_ULROW, S5_SPROW = 272;
__device__ __forceinline__ void s5_main_item(const Frame& F, const Args& a, int item) {
    const int g = item >> 2, b = (item >> 1) & 1, nt = item & 1, tid = F.tid, w = F.wave, lane = F.lane, r = lane & 31, hf = lane >> 5;
    LAS unsigned char* L = F.lds + RING_OFF;
    { const v4u* src = (const v4u*)((const bf16*)(a.ws + WS_KT) + (size_t)g * 65 * 256);
      for (int i = tid; i < 2080; i += NTHR) *(LAS v4u*)(L + S5_KTL + i * 16) = src[i];
      const v4u* us = (const v4u*)((const bf16*)(a.ws + WS_UT) + ((size_t)g * NTOK + (size_t)b * SEQ + (size_t)nt * 32 * 64) * 16);
#pragma unroll
      for (int i = 0; i < 8; ++i) { const int idx = tid + NTHR * i, row = idx >> 7, c16 = idx & 127; *(LAS v4u*)(L + S5_UL + row * S5_ULROW + c16 * 16) = us[idx]; } }
    { const v4u* sp = (const v4u*)((const bf16*)(a.ws + WS_SPV) + ((size_t)g * 128 + b * 64 + nt * 32) * 128);
      *(LAS v4u*)(L + S5_SPL + (tid >> 4) * S5_SPROW + (tid & 15) * 16) = sp[tid]; }
    __syncthreads();
    const bf16* W2 = (const bf16*)(a.ws + WS_W2) + (size_t)g * 1024 * 128;
    const bf16* UT = (const bf16*)(a.ws + WS_UT) + ((size_t)g * NTOK + (size_t)b * SEQ + (size_t)(nt * 32 + r) * 64) * 16;
    bf16* YP = (bf16*)(a.ws + WS_YPRE) + ((size_t)b * SEQ + (size_t)(nt * 32 + r) * 64) * DS5 + g * GH;
    const LAS unsigned char* aL = L + S5_KTL + r * 32 + hf * 16;
    const LAS unsigned char* bL = L + S5_UL + r * S5_ULROW + hf * 16;
    const LAS unsigned char* sL = L + S5_SPL + r * S5_SPROW + hf * 16;
#pragma unroll 1
    for (int q = 0; q < 4; ++q) {
        const int tb = (q == 0) ? w : (q == 1) ? 15 - w : (q == 2) ? 16 + w : 31 - w;
        bf16x8 wa[8];
        { const bf16* wp = W2 + (size_t)(tb * 32 + r) * 128 + 8 * hf;
#pragma unroll
          for (int ks = 0; ks < 8; ++ks) wa[ks] = *(const bf16x8*)(wp + ks * 16); }
        f32x16 acc = zero16();
        const int nj = 2 * tb + 2;
#pragma unroll 2
        for (int j = 0; j < nj; ++j) {
            const bf16x8 av = *(const LAS bf16x8*)(aL + (2 * tb - j + 1) * 512), bv = *(const LAS bf16x8*)(bL + j * 32);
            acc = MFMA32(av, bv, acc);
        }
#pragma unroll
        for (int ks = 0; ks < 8; ++ks) { const bf16x8 bv = *(const LAS bf16x8*)(sL + ks * 32); acc = MFMA32(wa[ks], bv, acc); }
#pragma unroll
        for (int qq = 0; qq < 4; ++qq) { const int t = 2 * tb + (qq >> 1), h0 = 8 * (qq & 1) + 4 * hf;
            const unsigned long long uw = *(const unsigned long long*)(UT + (size_t)t * 16 + h0);
            const f32x4 dv = *(const f32x4*)(a.in[I_D] + g * GH + h0);
            const float u0 = __builtin_bit_cast(float, (unsigned)(uw << 16)), u1 = __builtin_bit_cast(float, (unsigned)uw & 0xffff0000u),
                        u2 = __builtin_bit_cast(float, (unsigned)(uw >> 32) << 16), u3 = __builtin_bit_cast(float, (unsigned)(uw >> 32) & 0xffff0000u);
            const float y0 = gelu_tanh(acc[4 * qq] + dv[0] * u0), y1 = gelu_tanh(acc[4 * qq + 1] + dv[1] * u1), y2 = gelu_tanh(acc[4 * qq + 2] + dv[2] * u2), y3 = gelu_tanh(acc[4 * qq + 3] + dv[3] * u3);
            *(unsigned long long*)(YP + (size_t)t * DS5 + h0) = (unsigned long long)pg8::cvt_pk_bf16(y0, y1) | ((unsigned long long)pg8::cvt_pk_bf16(y2, y3) << 32); }
    }
    __syncthreads();
}

__device__ __forceinline__ float log_sigmoid_fast(float z) { return fminf(z, 0.f) - __logf(1.0f + __expf(-fabsf(z))); }
__device__ __forceinline__ bf16x8 gla_vfrag(const LAS unsigned short* VL, int sbase, int col, bool perm) {
    unsigned short x[8];
#pragma unroll
    for (int e = 0; e < 8; ++e) { const int s = perm ? (sbase + 8 * (e >> 2) + (e & 3)) : (sbase + e); x[e] = VL[s * 256 + col]; }
    v4u p; p.x = (unsigned)x[0] | ((unsigned)x[1] << 16); p.y = (unsigned)x[2] | ((unsigned)x[3] << 16); p.z = (unsigned)x[4] | ((unsigned)x[5] << 16); p.w = (unsigned)x[6] | ((unsigned)x[7] << 16);
    return __builtin_bit_cast(bf16x8, p);
}

constexpr int GL_TOT = 0, GL_GLW = 2048, GL_QL = 6144, GL_ROW = 272, GL_KL = GL_QL + 64 * GL_ROW, GL_KTT = GL_KL + 64 * GL_ROW, GL_KTROW = 144, GL_VL = GL_KTT + 128 * GL_KTROW;
static_assert(GL_VL + 32768 <= RING_BYTES, "GLA kv LDS map");
__device__ __forceinline__ void gla_kv_item(const Frame& F, const Args& a, int n) {
    const int bh = n >> 6, c = n & 63, b = bh >> 2, h = bh & 3, tid = F.tid, dk = tid & 127, tq = tid >> 7, w = F.wave, lane = F.lane, r = lane & 31, hf = lane >> 5;
    const size_t tok0 = (size_t)b * SEQ + (size_t)c * 64;
    LAS unsigned char* L = F.lds + RING_OFF;
    { const bf16* Q = (const bf16*)(a.ws + WS_Q) + tok0 * GDK + h * HK; const bf16* K = (const bf16*)(a.ws + WS_K) + tok0 * GDK + h * HK; const bf16* V = (const bf16*)(a.ws + WS_V) + tok0 * GDV + h * HV;
      v4u gq[2], gk[2], gv[4], gg;
#pragma unroll
      for (int i = 0; i < 2; ++i) { const int idx = tid + NTHR * i, row = idx >> 4, c16 = idx & 15; gq[i] = *(const v4u*)(Q + (size_t)row * GDK + c16 * 8); gk[i] = *(const v4u*)(K + (size_t)row * GDK + c16 * 8); }
#pragma unroll
      for (int i = 0; i < 4; ++i) { const int idx = tid + NTHR * i, row = idx >> 5, c16 = idx & 31; gv[i] = *(const v4u*)(V + (size_t)row * GDV + c16 * 8); }
      gg = (tid < 256) ? ((const v4u*)((const float*)(a.ws + WS_GLOW) + tok0 * 16))[tid] : (v4u){0u, 0u, 0u, 0u};
#pragma unroll
      for (int i = 0; i < 2; ++i) { const int idx = tid + NTHR * i, row = idx >> 4, c16 = idx & 15; *(LAS v4u*)(L + GL_QL + row * GL_ROW + c16 * 16) = gq[i]; *(LAS v4u*)(L + GL_KL + row * GL_ROW + c16 * 16) = gk[i]; }
#pragma unroll
      for (int i = 0; i < 4; ++i) { const int idx = tid + NTHR * i, row = idx >> 5, c16 = idx & 31; *(LAS v4u*)(L + GL_VL + row * 512 + c16 * 16) = gv[i]; }
      if (tid < 256) *(LAS v4u*)(L + GL_GLW + tid * 16) = gg; }
    float gu[RANK];
#pragma unroll
    for (int rr = 0; rr < RANK; ++rr) gu[rr] = a.in[I_GUP][rr * GDK + h * HK + dk];
    const float gb = a.in[I_GBIAS][h * HK + dk];
    __syncthreads();
    float bl[16]; float run = 0.f;
    { const LAS f32x4* GW = (const LAS f32x4*)(L + GL_GLW) + tq * 64;
#pragma unroll
      for (int i = 0; i < 16; ++i) { const f32x4 g0 = GW[i * 4], g1 = GW[i * 4 + 1], g2 = GW[i * 4 + 2], g3 = GW[i * 4 + 3];
        float z = gb;
        z += g0[0] * gu[0]; z += g0[1] * gu[1]; z += g0[2] * gu[2]; z += g0[3] * gu[3]; z += g1[0] * gu[4]; z += g1[1] * gu[5]; z += g1[2] * gu[6]; z += g1[3] * gu[7];
        z += g2[0] * gu[8]; z += g2[1] * gu[9]; z += g2[2] * gu[10]; z += g2[3] * gu[11]; z += g3[0] * gu[12]; z += g3[1] * gu[13]; z += g3[2] * gu[14]; z += g3[3] * gu[15];
        run += log_sigmoid_fast(z) * (1.0f / 16.0f); bl[i] = run; } }
    LAS float* TOT = (LAS float*)(L + GL_TOT);
    TOT[tq * 128 + dk] = run;
    __syncthreads();
    const float t0 = TOT[dk], t1 = TOT[128 + dk], t2 = TOT[256 + dk], t3 = TOT[384 + dk];
    const float off = (tq > 0 ? t0 : 0.f) + (tq > 1 ? t1 : 0.f) + (tq > 2 ? t2 : 0.f);
    const float blast = (t0 + t1) + (t2 + t3), elast = __expf(blast);
    { float kt[16];
#pragma unroll
      for (int i = 0; i < 16; ++i) { const float e = __expf(bl[i] + off), ei = __builtin_amdgcn_rcpf(e);
          LAS unsigned short* qp = (LAS unsigned short*)(L + GL_QL + (tq * 16 + i) * GL_ROW + dk * 2); LAS unsigned short* kp = (LAS unsigned short*)(L + GL_KL + (tq * 16 + i) * GL_ROW + dk * 2);
          const float ke = bf2f(*kp) * ei;
          *qp = f2bf16(bf2f(*qp) * e); *kp = f2bf16(ke); kt[i] = ke * elast; }
      v4u p0, p1; p0.x = pg8::cvt_pk_bf16(kt[0], kt[1]); p0.y = pg8::cvt_pk_bf16(kt[2], kt[3]); p0.z = pg8::cvt_pk_bf16(kt[4], kt[5]); p0.w = pg8::cvt_pk_bf16(kt[6], kt[7]);
      p1.x = pg8::cvt_pk_bf16(kt[8], kt[9]); p1.y = pg8::cvt_pk_bf16(kt[10], kt[11]); p1.z = pg8::cvt_pk_bf16(kt[12], kt[13]); p1.w = pg8::cvt_pk_bf16(kt[14], kt[15]);
      *(LAS v4u*)(L + GL_KTT + dk * GL_KTROW + tq * 32) = p0; *(LAS v4u*)(L + GL_KTT + dk * GL_KTROW + tq * 32 + 16) = p1;
      if (tq == 0) ((float*)(a.ws + WS_DEC))[(size_t)n * HK + dk] = elast; }
    __syncthreads();
    { bf16* QE = (bf16*)(a.ws + WS_QE) + (size_t)n * 64 * HK; bf16* KE = (bf16*)(a.ws + WS_KE) + (size_t)n * 64 * HK;
#pragma unroll
      for (int i = 0; i < 2; ++i) { const int idx = tid + NTHR * i, row = idx >> 4, c16 = idx & 15;
          *(v4u*)(QE + row * HK + c16 * 8) = *(const LAS v4u*)(L + GL_QL + row * GL_ROW + c16 * 16); *(v4u*)(KE + row * HK + c16 * 8) = *(const LAS v4u*)(L + GL_KL + row * GL_ROW + c16 * 16); } }
    f32x16 acc[4];
#pragma unroll
    for (int d = 0; d < 4; ++d) acc[d] = zero16();
#pragma unroll
    for (int ks = 0; ks < 4; ++ks) {
        const bf16x8 av = gla_vfrag((const LAS unsigned short*)(L + GL_VL), 16 * ks + 8 * hf, w * 32 + r, false);
#pragma unroll
        for (int d = 0; d < 4; ++d) { const bf16x8 bv = *(const LAS bf16x8*)(L + GL_KTT + (d * 32 + r) * GL_KTROW + ks * 32 + hf * 16); acc[d] = MFMA32(av, bv, acc[d]); }
    }
    bf16* KVT = (bf16*)(a.ws + WS_KVT) + ((size_t)n * HV + w * 32) * HK + r;
#pragma unroll
    for (int d = 0; d < 4; ++d)
#pragma unroll
        for (int rr = 0; rr < 16; ++rr) { const int dvl = (rr & 3) + 8 * (rr >> 2) + 4 * hf; KVT[(size_t)dvl * HK + d * 32] = f2bf16(acc[d][rr]); }
    __syncthreads();
}

__device__ __forceinline__ void gla_scan(const Args& a, int gtid, int gthreads) {
    for (int e2 = gtid; e2 < 8 * 256 * 64; e2 += gthreads) {
        const int bh = e2 >> 14, rem = e2 & 16383;
        const unsigned* KV = (const unsigned*)(a.ws + WS_KVT) + (size_t)bh * 64 * 16384 + rem;
        unsigned* SP = (unsigned*)(a.ws + WS_SPT) + (size_t)bh * 64 * 16384 + rem;
        const float* DEC = (const float*)(a.ws + WS_DEC) + (size_t)bh * 64 * HK + 2 * (rem & 63);
        float s0 = 0.f, s1 = 0.f;
#pragma unroll 1
        for (int cb = 0; cb < 8; ++cb) {
            unsigned kv[8]; float d0[8], d1[8];
#pragma unroll
            for (int i = 0; i < 8; ++i) { const int c = cb * 8 + i; kv[i] = KV[(size_t)c * 16384]; d0[i] = DEC[c * HK]; d1[i] = DEC[c * HK + 1]; }
#pragma unroll
            for (int i = 0; i < 8; ++i) { const int c = cb * 8 + i;
                SP[(size_t)c * 16384] = pg8::cvt_pk_bf16(s0, s1);
                s0 = d0[i] * s0 + __builtin_bit_cast(float, kv[i] << 16); s1 = d1[i] * s1 + __builtin_bit_cast(float, kv[i] & 0xffff0000u); }
        }
    }
}

constexpr int GO_QE = 0, GO_ROW = 272, GO_KE = GO_QE + 64 * GO_ROW, GO_VL = GO_KE + 64 * GO_ROW, GO_RED = GO_VL + 32768, GO_RS = GO_RED + 2048;
__device__ __forceinline__ void gla_out_item(const Frame& F, const Args& a, int n) {
    const int bh = n >> 6, c = n & 63, b = bh >> 2, h = bh & 3, tid = F.tid, w = F.wave, lane = F.lane, r = lane & 31, hf = lane >> 5;
    const size_t tok0 = (size_t)b * SEQ + (size_t)c * 64;
    LAS unsigned char* L = F.lds + RING_OFF;
    bf16x8 sa[8]; unsigned long long zw[2][4];
    { const bf16* QE = (const bf16*)(a.ws + WS_QE) + (size_t)n * 64 * HK; const bf16* KE = (const bf16*)(a.ws + WS_KE) + (size_t)n * 64 * HK; const bf16* V = (const bf16*)(a.ws + WS_V) + tok0 * GDV + h * HV;
      v4u gq[2], gk[2], gv[4];
#pragma unroll
      for (int i = 0; i < 2; ++i) { const int idx = tid + NTHR * i; gq[i] = ((const v4u*)QE)[idx]; gk[i] = ((const v4u*)KE)[idx]; }
#pragma unroll
      for (int i = 0; i < 4; ++i) { const int idx = tid + NTHR * i, row = idx >> 5, c16 = idx & 31; gv[i] = *(const v4u*)(V + (size_t)row * GDV + c16 * 8); }
      const bf16* SP = (const bf16*)(a.ws + WS_SPT) + ((size_t)n * HV + w * 32 + r) * HK + 8 * hf;
#pragma unroll
      for (int ks = 0; ks < 8; ++ks) sa[ks] = *(const bf16x8*)(SP + ks * 16);
      const bf16* ZG = (const bf16*)(a.ws + WS_ZGLA);
#pragma unroll
      for (int bb = 0; bb < 2; ++bb)
#pragma unroll
          for (int qq = 0; qq < 4; ++qq) zw[bb][qq] = *(const unsigned long long*)(ZG + (tok0 + bb * 32 + r) * GDV + h * HV + w * 32 + 8 * qq + 4 * hf);
#pragma unroll
      for (int i = 0; i < 2; ++i) { const int idx = tid + NTHR * i, row = idx >> 4, c16 = idx & 15; *(LAS v4u*)(L + GO_QE + row * GO_ROW + c16 * 16) = gq[i]; *(LAS v4u*)(L + GO_KE + row * GO_ROW + c16 * 16) = gk[i]; }
#pragma unroll
      for (int i = 0; i < 4; ++i) { const int idx = tid + NTHR * i, row = idx >> 5, c16 = idx & 31; *(LAS v4u*)(L + GO_VL + row * 512 + c16 * 16) = gv[i]; } }
    __syncthreads();
    f32x16 x00 = zero16(), x01 = zero16(), x11 = zero16();
#pragma unroll
    for (int ks = 0; ks < 8; ++ks) {
        const bf16x8 ka0 = *(const LAS bf16x8*)(L + GO_KE + r * GO_ROW + ks * 32 + hf * 16), ka1 = *(const LAS bf16x8*)(L + GO_KE + (32 + r) * GO_ROW + ks * 32 + hf * 16);
        const bf16x8 qb0 = *(const LAS bf16x8*)(L + GO_QE + r * GO_ROW + ks * 32 + hf * 16), qb1 = *(const LAS bf16x8*)(L + GO_QE + (32 + r) * GO_ROW + ks * 32 + hf * 16);
        x00 = MFMA32(ka0, qb0, x00); x01 = MFMA32(ka0, qb1, x01); x11 = MFMA32(ka1, qb1, x11);
    }
#pragma unroll
    for (int rr = 0; rr < 16; ++rr) { const int sl = (rr & 3) + 8 * (rr >> 2) + 4 * hf; if (sl > r) { x00[rr] = 0.f; x11[rr] = 0.f; } }
    f32x16 ot0 = zero16(), ot1 = zero16();
    const LAS unsigned short* VL = (const LAS unsigned short*)(L + GO_VL);
#pragma unroll
    for (int kk = 0; kk < 2; ++kk) {
        const bf16x8 va0 = gla_vfrag(VL, 16 * kk + 4 * hf, w * 32 + r, true), va1 = gla_vfrag(VL, 32 + 16 * kk + 4 * hf, w * 32 + r, true);
        ot0 = MFMA32(va0, pack_step(x00, kk), ot0);
        ot1 = MFMA32(va0, pack_step(x01, kk), ot1);
        ot1 = MFMA32(va1, pack_step(x11, kk), ot1);
    }
#pragma unroll
    for (int ks = 0; ks < 8; ++ks) {
        const bf16x8 qb0 = *(const LAS bf16x8*)(L + GO_QE + r * GO_ROW + ks * 32 + hf * 16), qb1 = *(const LAS bf16x8*)(L + GO_QE + (32 + r) * GO_ROW + ks * 32 + hf * 16);
        ot0 = MFMA32(sa[ks], qb0, ot0); ot1 = MFMA32(sa[ks], qb1, ot1); }
    { float s0 = 0.f, s1 = 0.f;
#pragma unroll
      for (int rr = 0; rr < 16; ++rr) { s0 += ot0[rr] * ot0[rr]; s1 += ot1[rr] * ot1[rr]; }
      s0 += __shfl_xor(s0, 32); s1 += __shfl_xor(s1, 32);
      LAS float* RED = (LAS float*)(L + GO_RED);
      if (hf == 0) { RED[w * 64 + r] = s0; RED[w * 64 + 32 + r] = s1; } }
    __syncthreads();
    if (tid < 64) { const LAS float* RED = (const LAS float*)(L + GO_RED); float t = 0.f;
#pragma unroll
        for (int ww = 0; ww < 8; ++ww) t += RED[ww * 64 + tid];
        ((LAS float*)(L + GO_RS))[tid] = 1.0f / sqrtf(t * (1.0f / HV) + EPS); }
    __syncthreads();
    { const LAS float* RS = (const LAS float*)(L + GO_RS); const float rs0 = RS[r], rs1 = RS[32 + r];
      bf16* CC = (bf16*)(a.ws + WS_CONCAT);
#pragma unroll
      for (int bb = 0; bb < 2; ++bb) { const size_t tok = tok0 + bb * 32 + r; const float rs = bb ? rs1 : rs0;
#pragma unroll
          for (int qq = 0; qq < 4; ++qq) { const int dv = w * 32 + 8 * qq + 4 * hf;
              const f32x4 nw = *(const f32x4*)(a.in[I_GNORM] + dv);
              const unsigned long long z = zw[bb][qq];
              const float z0 = __builtin_bit_cast(float, (unsigned)(z << 16)), z1 = __builtin_bit_cast(float, (unsigned)z & 0xffff0000u),
                          z2 = __builtin_bit_cast(float, (unsigned)(z >> 32) << 16), z3 = __builtin_bit_cast(float, (unsigned)(z >> 32) & 0xffff0000u);
              const f32x16& o = bb ? ot1 : ot0;
              const float y0 = o[4 * qq] * rs * nw[0] * z0, y1 = o[4 * qq + 1] * rs * nw[1] * z1, y2 = o[4 * qq + 2] * rs * nw[2] * z2, y3 = o[4 * qq + 3] * rs * nw[3] * z3;
              *(unsigned long long*)(CC + tok * 2048 + 1024 + h * HV + dv) = (unsigned long long)pg8::cvt_pk_bf16(y0, y1) | ((unsigned long long)pg8::cvt_pk_bf16(y2, y3) << 32); } } }
    __syncthreads();
}

constexpr int NPHASE = 7;
__global__ void __launch_bounds__(NTHR, 2) mega_fwd(Args a) {
    extern __shared__ __attribute__((aligned(16))) unsigned char lds[];
    Frame F;
    F.lds = (LAS unsigned char*)lds; F.MISC = (volatile LAS unsigned*)(F.lds + MISC_OFF);
    F.tid = threadIdx.x; F.lane = F.tid & 63; F.wave = __builtin_amdgcn_readfirstlane(F.tid >> 6);
    F.G = gridDim.x; { const int bx = blockIdx.x; F.vcu = (F.G % 8 == 0) ? (bx % 8) * (F.G / 8) + bx / 8 : bx; }
    F.ctl = (gu32*)(a.ws + WS_CTL);
    for (int u = F.tid; u < (LDS_BYTES - LDSCTL_OFF) / 4; u += NTHR) ((LAS unsigned*)(F.lds + LDSCTL_OFF))[u] = 0u;
    __syncthreads();
    const int lo = a.ph_lo, hi = a.ph_hi;
    const bool use_bar = (hi - lo) > 1;
    XcdBarrier bar; bar.bar = (unsigned*)(F.ctl + CW_BAR); bar.x = 0; bar.st = nullptr;
    if (use_bar) bar = xcd_barrier_post((unsigned*)(F.ctl + CW_BAR), F.MISC + 8);
#define IN(k) (lo <= (k) && (k) < hi)
#define SEAM(k) do { if (IN(k) && IN((k) + 1)) xcd_barrier(bar); } while (0)
    const int gtid = blockIdx.x * NTHR + F.tid, gthreads = F.G * NTHR;
    const int gw = blockIdx.x * NWAVES + F.wave, NGW = F.G * NWAVES;
    unsigned char* ws = a.ws;

    for (int rep_ = 0; rep_ < ((0 == REP_PHASE) ? 2 : 1); ++rep_) { if (rep_ == 1 && use_bar) xcd_barrier(bar);
    if (IN(0)) {
        p0_prologue(F, a);
    }
    }
    SEAM(0);

    for (int rep_ = 0; rep_ < ((1 == REP_PHASE) ? 2 : 1); ++rep_) { if (rep_ == 1 && use_bar) xcd_barrier(bar);
    if (IN(1)) {
        ProjSink ps{(bf16*)(ws + WS_UT), (bf16*)(ws + WS_ZS5), (bf16*)(ws + WS_Q), (bf16*)(ws + WS_K), (bf16*)(ws + WS_V), (bf16*)(ws + WS_ZGLA), (float*)(ws + WS_GLOW)};
#if FAST_GEMM
        pg8::Gemm g{(const pg8::bf16_t*)(ws + WS_XN), (const pg8::bf16_t*)(ws + WS_WIN), NTOK, DINP, DM}; pg8::StaticOrder S; S.init(NTOK, DINP, F.G, (int)blockIdx.x);
        pg8::Epi8<ProjSink> E{ps};
        pg8::gemm_phase<pg8::Epi8<ProjSink>, pg8::StaticOrder, PG8_ALIGN, PG8_SP2>(F.lds + RING_OFF, g, S, E);
        __syncthreads();
        if (F.G == 256 && blockIdx.x >= 160) {
            if (blockIdx.x < 224) {
#if FAST_S5
                s5_tables(F, a, (int)blockIdx.x - 160);
#endif
            } else late_transposes(F, a, ((int)blockIdx.x - 224) * NWAVES + F.wave, 32 * NWAVES);
        } else if (F.G != 256) {
#if FAST_S5
            for (int g = (int)blockIdx.x; g < 64; g += F.G) s5_tables(F, a, g);
#endif
            late_transposes(F, a, gw, NGW);
        }
#else
#if FAST_S5
        for (int g = (int)blockIdx.x; g < 64; g += F.G) s5_tables(F, a, g);
#endif
        late_transposes(F, a, gw, NGW);
        naive_gemm((const bf16*)(ws + WS_XN), (const bf16*)(ws + WS_WIN), NTOK, DINP, DM, ps, gtid, gthreads);
#endif
    }
    }
    SEAM(1);

    for (int rep_ = 0; rep_ < ((2 == REP_PHASE) ? 2 : 1); ++rep_) { if (rep_ == 1 && use_bar) xcd_barrier(bar);
    if (IN(2)) {
#if FAST_GLA
        for (int n = (int)blockIdx.x; n < 512; n += F.G) gla_kv_item(F, a, n);
#endif
#if FAST_S5
        for (int it = (int)blockIdx.x; it < 128; it += F.G) s5_sloc_item(F, a, it);
#endif
    }
    }
    SEAM(2);

    for (int rep_ = 0; rep_ < ((3 == REP_PHASE) ? 2 : 1); ++rep_) { if (rep_ == 1 && use_bar) xcd_barrier(bar);
    if (IN(3)) {
#if FAST_S5
        for (int it = (int)blockIdx.x; it < 256; it += F.G) s5_main_item(F, a, it);
#else
        if (blockIdx.x >= 8 && blockIdx.x < 8 + 16) s5_naive_item(a, ((int)blockIdx.x - 8) * NWAVES + F.wave, F.lane);
#endif
#if FAST_GLA
        gla_scan(a, gtid, gthreads);
#else
        if (blockIdx.x < 8) gla_naive_item(F, a, (int)blockIdx.x);
#endif
    }
    }
    SEAM(3);

    for (int rep_ = 0; rep_ < ((4 == REP_PHASE) ? 2 : 1); ++rep_) { if (rep_ == 1 && use_bar) xcd_barrier(bar);
    if (IN(4)) {
        GluSink gs{(const bf16*)(ws + WS_YPRE), (const bf16*)(ws + WS_ZS5), a.in[I_GLUB], (bf16*)(ws + WS_CONCAT)};
#if FAST_GEMM
        pg8::Gemm g{(const pg8::bf16_t*)(ws + WS_YPRE), (const pg8::bf16_t*)(ws + WS_WGLU), NTOK, DS5, DS5}; pg8::StaticOrder S; S.init(NTOK, DS5, F.G, (int)blockIdx.x);
        pg8::Epi8<GluSink> E{gs};
        pg8::gemm_phase<pg8::Epi8<GluSink>, pg8::StaticOrder, PG8_ALIGN, PG8_SP2>(F.lds + RING_OFF, g, S, E);
#else
        naive_gemm((const bf16*)(ws + WS_YPRE), (const bf16*)(ws + WS_WGLU), NTOK, DS5, DS5, gs, gtid, gthreads);
#endif
#if FAST_GLA
        __syncthreads();
        if (F.G == 256) { if (blockIdx.x >= 128) for (int n = (int)blockIdx.x - 128; n < 512; n += 128) gla_out_item(F, a, n); }
        else for (int n = (int)blockIdx.x; n < 512; n += F.G) gla_out_item(F, a, n);
#endif
    }
    }
    SEAM(4);

    for (int rep_ = 0; rep_ < ((5 == REP_PHASE) ? 2 : 1); ++rep_) { if (rep_ == 1 && use_bar) xcd_barrier(bar);
    if (IN(5)) {
        MixSink ms{(bf16*)(ws + WS_MIXED)};
#if FAST_GEMM
        pg8::Gemm g{(const pg8::bf16_t*)(ws + WS_CONCAT), (const pg8::bf16_t*)(ws + WS_WOUT), NTOK, DM, DM}; pg8::StaticOrder S; S.init(NTOK, DM, F.G, (int)blockIdx.x);
        pg8::Epi8<MixSink> E{ms};
        pg8::gemm_phase<pg8::Epi8<MixSink>, pg8::StaticOrder, PG8_ALIGN, PG8_SP2>(F.lds + RING_OFF, g, S, E);
#else
        naive_gemm((const bf16*)(ws + WS_CONCAT), (const bf16*)(ws + WS_WOUT), NTOK, DM, DM, ms, gtid, gthreads);
#endif
    }
    }
    SEAM(5);

    for (int rep_ = 0; rep_ < ((6 == REP_PHASE) ? 2 : 1); ++rep_) { if (rep_ == 1 && use_bar) xcd_barrier(bar);
    if (IN(6)) {
        p6_rows(a.in[I_X], (const bf16*)(ws + WS_MIXED), a.in[I_POSTW], a.out, gw, NGW, F.lane);
    }
    }
#undef IN
#undef SEAM
}

extern "C" void kernel_launch(void* const* d_in, const int* in_sizes, int n_in, void* d_out, int out_size, void* d_ws, size_t ws_size, hipStream_t stream) {
    static int grid = 0;
    if (grid == 0) {
        if (n_in != N_IN || out_size != NTOK * DM || ws_size < WS_END) { fprintf(stderr, "kernel_launch: unexpected problem shape (n_in %d out %d ws %zu)\n", n_in, out_size, ws_size); grid = -1; return; }
        int dev = 0, cus = 0;
        if (hipGetDevice(&dev) != hipSuccess || hipDeviceGetAttribute(&cus, hipDeviceAttributeMultiprocessorCount, dev) != hipSuccess) { grid = -1; return; }
        if (hipFuncSetAttribute((const void*)mega_fwd, hipFuncAttributeMaxDynamicSharedMemorySize, LDS_BYTES) != hipSuccess) { fprintf(stderr, "kernel_launch: hipFuncSetAttribute failed\n"); grid = -1; return; }
        grid = cus;
    }
    if (grid < 0) return;
    (void)hipMemsetAsync((char*)d_ws + WS_CTL, 0, CTL_ZERO_BYTES, stream);
    Args a{};
    for (int i = 0; i < N_IN; ++i) a.in[i] = (const float*)d_in[i];
    a.out = (float*)d_out; a.ws = (unsigned char*)d_ws;
#if MK_ONE_LAUNCH
    a.ph_lo = 0; a.ph_hi = NPHASE;
    hipLaunchKernelGGL(mega_fwd, dim3(grid), dim3(NTHR), LDS_BYTES, stream, a);
#else
    for (int p = 0; p < NPHASE; ++p) {
        if (p == 2 && !(FAST_S5 || FAST_GLA)) continue;
        a.ph_lo = p; a.ph_hi = p + 1;
        hipLaunchKernelGGL(mega_fwd, dim3(grid), dim3(NTHR), LDS_BYTES, stream, a);
        if (p == DUP_PHASE) hipLaunchKernelGGL(mega_fwd, dim3(grid), dim3(NTHR), LDS_BYTES, stream, a);
    }
#endif
}
```
